# Optimizing an MI355X kernel written in HIP

```python
import jax, jax.numpy as jnp
from jax import lax
import numpy as np

D_MODEL = 1024
BATCH = 8
SEQ = 4096
DEPTH = 2

HEAD_DIM = 64
N_HEADS_A = 6
N_HEADS_C = 6
WIDTH_A = N_HEADS_A * HEAD_DIM
WIDTH_C = N_HEADS_C * HEAD_DIM
WIDTH_B = D_MODEL - WIDTH_A - WIDTH_C
POOL_WINDOWS = (2, 4, 8, 16)
N_POOL_GROUPS = len(POOL_WINDOWS)
POOL_GROUP_DIM = WIDTH_B // N_POOL_GROUPS
DILATED_CONFIGS = ((128, 1), (512, 4), (2048, 16))
GRID_W = 64
NA_ROWS_MAX = 8
NA_COLS = 16
D_FF = -(-(8 * D_MODEL) // (3 * 256)) * 256
PROJ_WIDTH = 3 * WIDTH_A + WIDTH_B + 3 * WIDTH_C
EPS = 1e-6
NEG = -1e30

kernel_name = "hybrid_dilated_pool_neighbourhood_encoder"


def rmsnorm(x, g):
    xf = x.astype(jnp.float32)
    y = xf * lax.rsqrt(jnp.mean(xf * xf, axis=-1, keepdims=True) + EPS)
    return (y * g.astype(jnp.float32)).astype(x.dtype)


def to_heads(a, n_heads):
    b, s, _ = a.shape
    return a.reshape(b, s, n_heads, HEAD_DIM).transpose(0, 2, 1, 3)


def from_heads(a):
    b, h, s, d = a.shape
    return a.transpose(0, 2, 1, 3).reshape(b, s, h * d)


def dilated_window_branch(q, k, v, slopes, window, dil):
    B, H, S, hd = q.shape
    half = window // (2 * dil)
    blk = half
    chunk = dil * blk
    L = -(-S // chunk) * chunk
    n = L // dil
    nb = n // blk

    def prep(a):
        a = jnp.pad(a, ((0, 0), (0, 0), (0, L - S), (0, 0)))
        a = a.reshape(B, H, n, dil, hd).transpose(0, 1, 3, 2, 4)
        return a.reshape(B, H, dil, nb, blk, hd)

    def band(a):
        z = jnp.zeros_like(a[:, :, :, :1])
        prev = jnp.concatenate([z, a[:, :, :, :-1]], axis=3)
        nxt = jnp.concatenate([a[:, :, :, 1:], z], axis=3)
        return jnp.concatenate([prev, a, nxt], axis=4)

    qb = prep(q)
    kn = band(prep(k))
    vn = band(prep(v))

    qi = jnp.arange(nb)[:, None] * blk + jnp.arange(blk)[None, :]
    ki = (jnp.arange(nb)[:, None] - 1) * blk + jnp.arange(3 * blk)[None, :]
    rel = ki[:, None, :] - qi[:, :, None]
    kpos = ki[None] * dil + jnp.arange(dil)[:, None, None]
    kvalid = (ki >= 0)[None] & (kpos < S)
    allowed = (jnp.abs(rel) <= half)[None] & kvalid[:, :, None, :]
    dist = (jnp.abs(rel) * dil).astype(jnp.float32)

    s = jnp.einsum('bhrnqd,bhrnkd->bhrnqk', qb, kn,
                   preferred_element_type=jnp.float32) * (hd ** -0.5)
    s = s - slopes[None, :, None, None, None, None] * dist[None, None, None]
    s = jnp.where(allowed[None, None], s, NEG)
    m = jnp.max(s, axis=-1, keepdims=True)
    p = jnp.exp(s - m)
    den = jnp.sum(p, axis=-1)
    o = jnp.einsum('bhrnqk,bhrnkd->bhrnqd', p.astype(v.dtype), vn,
                   preferred_element_type=jnp.float32) / den[..., None]
    lse = m[..., 0] + jnp.log(den)
    o = o.reshape(B, H, dil, n, hd).transpose(0, 1, 3, 2, 4).reshape(B, H, L, hd)[:, :, :S]
    lse = lse.reshape(B, H, dil, n).transpose(0, 1, 3, 2).reshape(B, H, L)[:, :, :S]
    return o, lse


def dilated_mixture_attention(q, k, v):
    n_h = q.shape[1]
    slopes = 2.0 ** (-8.0 * (jnp.arange(n_h, dtype=jnp.float32) + 1.0) / n_h)
    outs, lses = [], []
    for window, dil in DILATED_CONFIGS:
        o, lse = dilated_window_branch(q, k, v, slopes, window, dil)
        outs.append(o)
        lses.append(lse)
    w = jax.nn.softmax(jnp.stack(lses, axis=0), axis=0)
    return jnp.sum(w[..., None] * jnp.stack(outs, axis=0), axis=0)


def neighbourhood_attention(q, k, v, rpb):
    B, H, S, hd = q.shape
    R = S // GRID_W
    wr = min(NA_ROWS_MAX, R)
    q = q.reshape(B, H, R, GRID_W, hd)
    k = k.reshape(B, H, R, GRID_W, hd)
    v = v.reshape(B, H, R, GRID_W, hd)
    rows = jnp.arange(R)
    rstart = jnp.clip(rows - wr // 2, 0, R - wr)
    krow = rstart[:, None] + jnp.arange(wr)[None, :]
    kg = k[:, :, krow]
    vg = v[:, :, krow]
    cols = jnp.arange(GRID_W)
    cstart = jnp.clip(cols - NA_COLS // 2, 0, GRID_W - NA_COLS)
    col_in = (cols[None, :] >= cstart[:, None]) & (cols[None, :] < cstart[:, None] + NA_COLS)
    s = jnp.einsum('bhrqd,bhrikd->bhrqik', q, kg,
                   preferred_element_type=jnp.float32) * (hd ** -0.5)
    dr = krow - rows[:, None] + (NA_ROWS_MAX - 1)
    dc = jnp.clip(cols[None, :] - cols[:, None] + NA_COLS - 1, 0, 2 * NA_COLS - 2)
    bias = rpb[:, dr[:, None, :, None], dc[None, :, None, :]]
    s = s + bias[None].astype(jnp.float32)
    s = jnp.where(col_in[:, None, :], s, NEG)
    p = jax.nn.softmax(s, axis=(-2, -1))
    o = jnp.einsum('bhrqik,bhrikd->bhrqd', p.astype(v.dtype), vg,
                   preferred_element_type=jnp.float32)
    return o.reshape(B, H, S, hd)


def multiscale_pool(u, w_pool, pool_scale):
    B, S, _ = u.shape
    uf = u.astype(jnp.float32)
    csum = jnp.concatenate([jnp.zeros((B, 1, WIDTH_B), jnp.float32), jnp.cumsum(uf, axis=1)], axis=1)
    t = jnp.arange(S)
    outs = []
    for g, w in enumerate(POOL_WINDOWS):
        lo = jnp.clip(t - w // 2, 0, S - 1)
        hi = jnp.clip(t + w // 2 - 1, 0, S - 1)
        seg = csum[:, :, g * POOL_GROUP_DIM:(g + 1) * POOL_GROUP_DIM]
        tot = seg[:, hi + 1] - seg[:, lo]
        cnt = (hi - lo + 1).astype(jnp.float32)
        outs.append(tot / cnt[None, :, None])
    pooled = jnp.concatenate(outs, axis=-1) - uf
    pooled = pooled.reshape(B, S, N_POOL_GROUPS, POOL_GROUP_DIM)
    y = jnp.einsum('bsgc,gcd->bsgd', pooled, w_pool.astype(jnp.float32)).reshape(B, S, WIDTH_B)
    return y * pool_scale.astype(jnp.float32)


def setup_inputs(seed: int = 0) -> dict:
    key = jax.random.key(seed)
    ks = jax.random.split(key, 16)
    f32 = jnp.float32
    nrm = lambda k, shape, sc: jax.random.normal(k, shape, f32) * sc
    return {
        "x": nrm(ks[0], (BATCH, SEQ, D_MODEL), 1.0),
        "c": nrm(ks[1], (BATCH, D_MODEL), 1.0),
        "w_ada": nrm(ks[2], (DEPTH, D_MODEL, 6 * D_MODEL), D_MODEL ** -0.5),
        "b_ada": nrm(ks[3], (DEPTH, 6 * D_MODEL), 0.02),
        "norm_mix": 1.0 + nrm(ks[4], (DEPTH, D_MODEL), 0.05),
        "w_in": nrm(ks[5], (DEPTH, D_MODEL, PROJ_WIDTH), D_MODEL ** -0.5),
        "norm_a_out": 1.0 + nrm(ks[6], (DEPTH, WIDTH_A), 0.05),
        "norm_c_out": 1.0 + nrm(ks[7], (DEPTH, WIDTH_C), 0.05),
        "w_pool": nrm(ks[8], (DEPTH, N_POOL_GROUPS, POOL_GROUP_DIM, POOL_GROUP_DIM), POOL_GROUP_DIM ** -0.5),
        "pool_scale": 1.0 + nrm(ks[9], (DEPTH, WIDTH_B), 0.1),
        "rpb": nrm(ks[10], (DEPTH, N_HEADS_C, 2 * NA_ROWS_MAX - 1, 2 * NA_COLS - 1), 0.1),
        "w_out": nrm(ks[11], (DEPTH, D_MODEL, D_MODEL), D_MODEL ** -0.5),
        "norm_ffn": 1.0 + nrm(ks[12], (DEPTH, D_MODEL), 0.05),
        "w_ffn_in": nrm(ks[13], (DEPTH, D_MODEL, 2 * D_FF), D_MODEL ** -0.5),
        "w_ffn_out": nrm(ks[14], (DEPTH, D_FF, D_MODEL), D_FF ** -0.5),
        "norm_final": 1.0 + nrm(ks[15], (D_MODEL,), 0.05),
    }


def reference(x, c, w_ada, b_ada, norm_mix, w_in, norm_a_out, norm_c_out, w_pool,
              pool_scale, rpb, w_out, norm_ffn, w_ffn_in, w_ffn_out, norm_final):
    dt = x.dtype
    c_act = jax.nn.silu(c)
    splits = np.cumsum([WIDTH_A, WIDTH_A, WIDTH_A, WIDTH_B, WIDTH_C, WIDTH_C]).tolist()
    for l in range(DEPTH):
        mod = c_act @ w_ada[l] + b_ada[l]
        sh1, sc1, g1, sh2, sc2, g2 = jnp.split(mod, 6, axis=-1)

        h = rmsnorm(x, norm_mix[l]) * (1.0 + sc1[:, None]) + sh1[:, None]
        z = h @ w_in[l]
        qa, ka, va, ub, qc, kc, vc = jnp.split(z, splits, axis=-1)

        oa = dilated_mixture_attention(to_heads(qa, N_HEADS_A), to_heads(ka, N_HEADS_A),
                                       to_heads(va, N_HEADS_A))
        oa = rmsnorm(from_heads(oa), norm_a_out[l]).astype(dt)
        ob = multiscale_pool(ub, w_pool[l], pool_scale[l]).astype(dt)
        oc = neighbourhood_attention(to_heads(qc, N_HEADS_C), to_heads(kc, N_HEADS_C),
                                     to_heads(vc, N_HEADS_C), rpb[l])
        oc = rmsnorm(from_heads(oc), norm_c_out[l]).astype(dt)

        mix = jnp.concatenate([oa, ob, oc], axis=-1) @ w_out[l]
        x = x + g1[:, None] * mix

        h2 = rmsnorm(x, norm_ffn[l]) * (1.0 + sc2[:, None]) + sh2[:, None]
        gate, up = jnp.split(h2 @ w_ffn_in[l], 2, axis=-1)
        ffn = (jax.nn.silu(gate) * up) @ w_ffn_out[l]
        x = x + g2[:, None] * ffn
    return rmsnorm(x, norm_final)
```

```cpp
#include <hip/hip_runtime.h>
#include <hip/hip_cooperative_groups.h>
#include <cstdio>
#include <cstdint>
namespace cg = cooperative_groups;
#ifndef MK_PER_PHASE
#define MK_PER_PHASE 0
#endif
namespace pg8 {
#define PG8_LAS __attribute__((address_space(3)))
typedef unsigned short bf16_t;
typedef short bf16x8 __attribute__((ext_vector_type(8)));
typedef float f32x4 __attribute__((ext_vector_type(4)));
typedef unsigned u32x4 __attribute__((ext_vector_type(4)));
constexpr int BM = 256, BK = 64, HALF = 128, HTB = HALF * BK * 2  , STAGE_BYTES = 8 * HTB, NXCD = 8, WGM = 8;

__host__ __device__ __forceinline__ int lds_byte(int r, int c) { const int st = (r >> 4) * 2 + (c >> 5), rr = r & 15, cc = c & 31, ob = rr * 64 + cc * 2; return st * 1024 + (ob ^ (((ob >> 9) & 1) << 5)); }
__host__ __device__ __forceinline__ void stage_rc(int b, int& R, int& C) { const int st = b / 1024, sb = b % 1024, swz = sb ^ (((sb >> 9) & 1) << 5); R = (st >> 1) * 16 + swz / 64; C = (st & 1) * 32 + (swz % 64) / 2; }
__host__ __device__ __forceinline__ int perm32(int rho) { const int n = rho >> 4, i = rho & 15; return 8 * (i >> 2) + 4 * n + (i & 3); }

struct Unit { int pm, pn; };
struct Gemm { const bf16_t* A; const bf16_t* Bt; int M, N, K; size_t agap; };

struct StaticOrder {
    int nM, nN, nwg, G, c;
    __host__ __device__ void init(int M, int N, int G_, int c_) { nM = M / BM; nN = N / BM; nwg = nM * nN; G = G_; c = c_; }
    __host__ __device__ bool next(int i, Unit& u) const {
        const long L = (long)i * G + c; if (L >= nwg) return false;
        int wgid = (int)L; { const int q = nwg / NXCD, r = nwg % NXCD, xcd = wgid % NXCD, off = wgid / NXCD; wgid = (xcd < r ? xcd * (q + 1) : r * (q + 1) + (xcd - r) * q) + off; }
        const int nig = WGM * nN, gid = wgid / nig, fm = gid * WGM, gsz = (nM - fm) < WGM ? (nM - fm) : WGM;
        u.pm = fm + ((wgid % nig) % gsz); u.pn = (wgid % nig) / gsz; return true;
    }
    __device__ __forceinline__ void a_ready(const Unit&) const {}
    __device__ __forceinline__ void done(const Unit&) const {}
};

__device__ __forceinline__ unsigned cvt_pk_bf16(float lo, float hi) { unsigned r; asm volatile("v_cvt_pk_bf16_f32 %0, %1, %2" : "=v"(r) : "v"(lo), "v"(hi)); return r; }
typedef float f32x2 __attribute__((ext_vector_type(2)));
typedef unsigned u32x2 __attribute__((ext_vector_type(2)));
__device__ __forceinline__ float silu_f(float g) { return g * __builtin_amdgcn_rcpf(1.0f + __builtin_amdgcn_exp2f(-1.4426950408889634f * g)); }
struct EpiZH {
    static constexpr bool PERM = true, AFTER_DRAIN = false;
    static constexpr size_t SEG = (size_t)6 * 4096 * 64, BLK = (size_t)14 << 20;
    bf16_t* Zh;
    __device__ __forceinline__ void operator()(const f32x4 (&acc)[2][2][4][2], const Unit& u, int wr, int wc, int fr, int fq) const {
        const int m0 = u.pm * BM, b = m0 >> 12, t0 = (m0 & 4095) + wr * 64 + fr;
#pragma unroll
        for (int bj = 0; bj < 2; ++bj) {
            const int colw = u.pn * BM + bj * HALF + wc * 32;
            bf16_t* dst; int ld; float qs = 1.0f;
            if (colw >= 1152 && colw < 1408) { dst = Zh + (size_t)b * BLK + 6 * SEG + (colw - 1152) + 8 * fq; ld = 256; }
            else { const int cc = colw < 1152 ? colw : colw - 1408, seg = (colw < 1152 ? 0 : 3) + cc / 384, rem = cc % 384, h = rem >> 6, d0 = rem & 63;
                   dst = Zh + (size_t)b * BLK + (size_t)seg * SEG + (size_t)h * 4096 * 64 + d0 + 8 * fq; ld = 64; qs = (seg == 0 || seg == 3) ? 0.125f * 1.4426950408889634f : 1.0f; }
#pragma unroll
            for (int ai = 0; ai < 2; ++ai)
#pragma unroll
                for (int m = 0; m < 4; ++m) { const f32x4 v0 = acc[ai][bj][m][0] * qs, v1 = acc[ai][bj][m][1] * qs;
                    u32x4 w; w.x = cvt_pk_bf16(v0[0], v0[1]); w.y = cvt_pk_bf16(v0[2], v0[3]); w.z = cvt_pk_bf16(v1[0], v1[1]); w.w = cvt_pk_bf16(v1[2], v1[3]);
                    *(u32x4*)(dst + (size_t)(t0 + ai * HALF + m * 16) * ld) = w; } }
    }
};
struct EpiSwiGLU {
    static constexpr bool PERM = true, AFTER_DRAIN = false;
    bf16_t* O; int ldc; size_t ogap;
    __device__ __forceinline__ void operator()(const f32x4 (&acc)[2][2][4][2], const Unit& u, int wr, int wc, int fr, int fq) const {
        const int row0 = u.pm * BM + wr * 64 + fr, col0 = u.pn * HALF + wc * 32 + 8 * fq;
#pragma unroll
        for (int ai = 0; ai < 2; ++ai)
#pragma unroll
            for (int m = 0; m < 4; ++m) { bf16_t* rowp = O + (size_t)(row0 + ai * HALF + m * 16) * ldc + (size_t)(u.pm >> 4) * ogap + col0;
                const f32x4 g0 = acc[ai][0][m][0], g1 = acc[ai][0][m][1], u0 = acc[ai][1][m][0], u1 = acc[ai][1][m][1];
                u32x4 w; w.x = cvt_pk_bf16(silu_f(g0[0]) * u0[0], silu_f(g0[1]) * u0[1]); w.y = cvt_pk_bf16(silu_f(g0[2]) * u0[2], silu_f(g0[3]) * u0[3]);
                w.z = cvt_pk_bf16(silu_f(g1[0]) * u1[0], silu_f(g1[1]) * u1[1]); w.w = cvt_pk_bf16(silu_f(g1[2]) * u1[2], silu_f(g1[3]) * u1[3]);
                *(u32x4*)rowp = w; }
    }
};
template <bool BASE_F32>
struct EpiResid {
    static constexpr bool PERM = true, AFTER_DRAIN = false;
    const void* base; bf16_t* out; const float* gate;
    __device__ __forceinline__ void operator()(const f32x4 (&acc)[2][2][4][2], const Unit& u, int wr, int wc, int fr, int fq) const {
        const int row0 = u.pm * BM + wr * 64 + fr, col0 = u.pn * BM + wc * 32 + 8 * fq;
        const float* gp = gate + (size_t)(u.pm >> 4) * 6144 + col0;
        f32x4 gv[2][2];
#pragma unroll
        for (int bj = 0; bj < 2; ++bj)
#pragma unroll
            for (int n = 0; n < 2; ++n) gv[bj][n] = *(const f32x4*)(gp + bj * HALF + n * 4);
        constexpr int MB = BASE_F32 ? 1 : 4;
#pragma unroll
        for (int ai = 0; ai < 2; ++ai)
#pragma unroll
            for (int mb = 0; mb < 4; mb += MB) {
                f32x4 bl[MB][2][2]; u32x4 bw[MB][2];
#pragma unroll
                for (int mi = 0; mi < MB; ++mi) { const size_t off = (size_t)(row0 + ai * HALF + (mb + mi) * 16) * 1024 + col0;
#pragma unroll
                    for (int bj = 0; bj < 2; ++bj) {
                        if (BASE_F32) { bl[mi][bj][0] = *(const f32x4*)((const float*)base + off + bj * HALF); bl[mi][bj][1] = *(const f32x4*)((const float*)base + off + bj * HALF + 4); }
                        else bw[mi][bj] = *(const u32x4*)((const bf16_t*)base + off + bj * HALF); } }
#pragma unroll
                for (int mi = 0; mi < MB; ++mi) { const int m = mb + mi; const size_t off = (size_t)(row0 + ai * HALF + m * 16) * 1024 + col0;
#pragma unroll
                    for (int bj = 0; bj < 2; ++bj) { f32x4 b0, b1;
                        if (BASE_F32) { b0 = bl[mi][bj][0]; b1 = bl[mi][bj][1]; }
                        else { const u32x4 w = bw[mi][bj];
                               b0 = (f32x4){__builtin_bit_cast(float, w.x << 16), __builtin_bit_cast(float, w.x & 0xffff0000u), __builtin_bit_cast(float, w.y << 16), __builtin_bit_cast(float, w.y & 0xffff0000u)};
                               b1 = (f32x4){__builtin_bit_cast(float, w.z << 16), __builtin_bit_cast(float, w.z & 0xffff0000u), __builtin_bit_cast(float, w.w << 16), __builtin_bit_cast(float, w.w & 0xffff0000u)}; }
                        const f32x4 o0 = b0 + gv[bj][0] * acc[ai][bj][m][0], o1 = b1 + gv[bj][1] * acc[ai][bj][m][1];
                        u32x4 r; r.x = cvt_pk_bf16(o0[0], o0[1]); r.y = cvt_pk_bf16(o0[2], o0[3]); r.z = cvt_pk_bf16(o1[0], o1[1]); r.w = cvt_pk_bf16(o1[2], o1[3]);
                        *(u32x4*)(out + off + bj * HALF) = r; } }
                asm volatile("" ::: "memory"); }
    }
};
template <class Epi, class Sched, bool ALIGN_EPI = false, bool SP2 = false>
__device__ __forceinline__ void gemm_phase(PG8_LAS unsigned char* lds, const Gemm g, const Sched& S, const Epi& E, const int tid) {
    const int wid = __builtin_amdgcn_readfirstlane(tid >> 6), lane = tid & 63, wr = wid >> 2, wc = wid & 3, fr = lane & 15, fq = lane >> 4;
    const int K = g.K, nt = K / BK;
    unsigned voffA[2], voffB[2];
#pragma unroll
    for (int i = 0; i < 2; ++i) { int R, C; stage_rc(tid * 16 + i * 8192, R, C); const int Rb = Epi::PERM ? ((R & ~31) + perm32(R & 31)) : R;
        voffA[i] = (unsigned)(R * K + C) * 2u; voffB[i] = (unsigned)(Rb * K + C) * 2u; }
    const size_t kstep = (size_t)(BK * 2);
    const size_t hstep = (size_t)HALF * K * 2;
    const size_t tstep = 2 * hstep;
    const unsigned ldsw = (unsigned)wid * 1024u;
    const int aoff = lds_byte(wr * 64 + fr, fq * 8), boff = lds_byte(wc * 32 + fr, fq * 8);
#define PG8_SA(b, h) (((b) * 2 + (h)) * HTB)
#define PG8_SB(b, h) ((4 + (b) * 2 + (h)) * HTB)
#define PG8_STAGE(bufoff, gbase, voff) do { _Pragma("unroll") for (int _i = 0; _i < 2; ++_i) \
        __builtin_amdgcn_global_load_lds((const unsigned*)((const char*)(gbase) + (voff)[_i]), (PG8_LAS unsigned*)(lds + (bufoff) + ldsw + _i * 8192), 16, 0, 0); } while (0)
#define PG8_LDA(dst, b, h) do { _Pragma("unroll") for (int m = 0; m < 4; ++m) _Pragma("unroll") for (int k = 0; k < 2; ++k) dst[m][k] = *(const PG8_LAS bf16x8*)(lds + PG8_SA(b, h) + aoff + m * 2048 + k * 1024); } while (0)
#define PG8_LDB(dst, b, h) do { _Pragma("unroll") for (int n = 0; n < 2; ++n) _Pragma("unroll") for (int k = 0; k < 2; ++k) dst[n][k] = *(const PG8_LAS bf16x8*)(lds + PG8_SB(b, h) + boff + n * 2048 + k * 1024); } while (0)
#define PG8_MMA(ai, bj, At, Bt) do { __builtin_amdgcn_s_setprio(1); _Pragma("unroll") for (int m = 0; m < 4; ++m) _Pragma("unroll") for (int n = 0; n < 2; ++n) _Pragma("unroll") for (int k = 0; k < 2; ++k) \
        acc[ai][bj][m][n] = __builtin_amdgcn_mfma_f32_16x16x32_bf16(Bt[n][k], At[m][k], acc[ai][bj][m][n], 0, 0, 0); __builtin_amdgcn_s_setprio(0); } while (0)
#define PG8_WAIT_V(n) asm volatile("s_waitcnt vmcnt(" #n ")" ::: "memory")
#define PG8_WAIT_L(n) asm volatile("s_waitcnt lgkmcnt(" #n ")" ::: "memory")
#define PG8_BAR __builtin_amdgcn_s_barrier()
#define PG8_SCHED __builtin_amdgcn_sched_barrier(0)
    Unit cur, nxt; int ui = 0;
    if (!S.next(0, cur)) return;
    f32x4 acc[2][2][4][2];
#pragma unroll
    for (int a = 0; a < 2; ++a)
#pragma unroll
        for (int b = 0; b < 2; ++b)
#pragma unroll
            for (int m = 0; m < 4; ++m)
#pragma unroll
                for (int n = 0; n < 2; ++n) acc[a][b][m][n] = (f32x4){0.f, 0.f, 0.f, 0.f};
    bf16x8 At[4][2], B0[2][2], B1[2][2];
    const char* cA = (const char*)g.A + (size_t)cur.pm * tstep + (size_t)(cur.pm >> 4) * g.agap * 2; const char* cB = (const char*)g.Bt + (size_t)cur.pn * tstep;
    S.a_ready(cur);
    if constexpr (SP2) {
        PG8_STAGE(PG8_SB(0, 0), cB, voffB); PG8_STAGE(PG8_SB(0, 1), cB + hstep, voffB); PG8_STAGE(PG8_SA(0, 0), cA, voffA); PG8_STAGE(PG8_SA(0, 1), cA + hstep, voffA);
        if (wr == 1) PG8_BAR;
        PG8_WAIT_V(2); PG8_BAR;
        PG8_STAGE(PG8_SB(1, 0), cB + kstep, voffB); PG8_STAGE(PG8_SA(1, 0), cA + kstep, voffA); PG8_STAGE(PG8_SB(1, 1), cB + hstep + kstep, voffB);
        PG8_WAIT_V(6); PG8_BAR;
    } else {
        PG8_STAGE(PG8_SB(0, 0), cB, voffB); PG8_STAGE(PG8_SA(0, 0), cA, voffA); PG8_STAGE(PG8_SB(0, 1), cB + hstep, voffB); PG8_STAGE(PG8_SA(0, 1), cA + hstep, voffA);
        if (wr == 1) PG8_BAR;
        PG8_WAIT_V(4); PG8_BAR;
        PG8_STAGE(PG8_SB(1, 0), cB + kstep, voffB); PG8_STAGE(PG8_SA(1, 0), cA + kstep, voffA); PG8_STAGE(PG8_SB(1, 1), cB + hstep + kstep, voffB);
        PG8_WAIT_V(6); PG8_BAR;
    }
    for (;;) {
        const bool has_next = S.next(ui + 1, nxt);
        const char* nA = has_next ? (const char*)g.A + (size_t)nxt.pm * tstep + (size_t)(nxt.pm >> 4) * g.agap * 2 : cA; const char* nB = has_next ? (const char*)g.Bt + (size_t)nxt.pn * tstep : cB;
        for (int t = 0; t < nt; t += 2) {
            const bool last = (t == nt - 2);
            const char* a1 = cA + (size_t)(t + 1) * kstep;
            const char* a2 = last ? nA : cA + (size_t)(t + 2) * kstep; const char* b2 = last ? nB : cB + (size_t)(t + 2) * kstep;
            const char* a3 = a2 + kstep; const char* b3 = b2 + kstep;
            if (last && has_next) S.a_ready(nxt);
            if constexpr (SP2) {
            PG8_LDB(B0, 0, 0); PG8_LDB(B1, 0, 1); PG8_SCHED; PG8_LDA(At, 0, 0); PG8_STAGE(PG8_SA(1, 1), a1 + hstep, voffA);
            PG8_WAIT_V(8); PG8_WAIT_L(0); PG8_BAR; PG8_MMA(0, 0, At, B0); PG8_MMA(0, 1, At, B1); PG8_BAR; PG8_SCHED;
            PG8_LDA(At, 0, 1); PG8_STAGE(PG8_SB(0, 0), b2, voffB); PG8_STAGE(PG8_SB(0, 1), b2 + hstep, voffB); PG8_STAGE(PG8_SA(0, 0), a2, voffA);
            PG8_WAIT_V(8); PG8_WAIT_L(0); PG8_BAR; PG8_MMA(1, 0, At, B0); PG8_MMA(1, 1, At, B1); PG8_BAR; PG8_SCHED;
            PG8_LDB(B0, 1, 0); PG8_LDB(B1, 1, 1); PG8_SCHED; PG8_LDA(At, 1, 0); PG8_STAGE(PG8_SA(0, 1), a2 + hstep, voffA);
            PG8_WAIT_V(8); PG8_WAIT_L(0); PG8_BAR; PG8_MMA(0, 0, At, B0); PG8_MMA(0, 1, At, B1); PG8_BAR; PG8_SCHED;
            PG8_LDA(At, 1, 1); PG8_STAGE(PG8_SB(1, 0), b3, voffB); PG8_STAGE(PG8_SB(1, 1), b3 + hstep, voffB); PG8_STAGE(PG8_SA(1, 0), a3, voffA);
            PG8_WAIT_V(8); PG8_WAIT_L(0); PG8_BAR; PG8_MMA(1, 0, At, B0); PG8_MMA(1, 1, At, B1); PG8_BAR; PG8_SCHED;
            } else {
            PG8_LDB(B0, 0, 0); PG8_SCHED; PG8_LDA(At, 0, 0); PG8_STAGE(PG8_SA(1, 1), a1 + hstep, voffA);
            PG8_WAIT_L(8); PG8_BAR; PG8_WAIT_L(0); PG8_MMA(0, 0, At, B0); PG8_BAR; PG8_SCHED;
            PG8_LDB(B1, 0, 1); PG8_STAGE(PG8_SB(0, 0), b2, voffB);
            PG8_BAR; PG8_WAIT_L(0); PG8_MMA(0, 1, At, B1); PG8_BAR;
            PG8_LDA(At, 0, 1); PG8_STAGE(PG8_SA(0, 0), a2, voffA);
            PG8_BAR; PG8_WAIT_L(0); PG8_MMA(1, 0, At, B0); PG8_BAR; PG8_SCHED;
            PG8_STAGE(PG8_SB(0, 1), b2 + hstep, voffB);
            PG8_WAIT_V(6); PG8_BAR; PG8_MMA(1, 1, At, B1); PG8_BAR;
            PG8_LDB(B0, 1, 0); PG8_SCHED; PG8_LDA(At, 1, 0); PG8_STAGE(PG8_SA(0, 1), a2 + hstep, voffA);
            PG8_WAIT_L(8); PG8_BAR; PG8_WAIT_L(0); PG8_MMA(0, 0, At, B0); PG8_BAR; PG8_SCHED;
            PG8_LDB(B1, 1, 1); PG8_STAGE(PG8_SB(1, 0), b3, voffB);
            PG8_BAR; PG8_WAIT_L(0); PG8_MMA(0, 1, At, B1); PG8_BAR;
            PG8_LDA(At, 1, 1); PG8_STAGE(PG8_SA(1, 0), a3, voffA);
            PG8_BAR; PG8_WAIT_L(0); PG8_MMA(1, 0, At, B0); PG8_BAR; PG8_SCHED;
            PG8_STAGE(PG8_SB(1, 1), b3 + hstep, voffB);
            PG8_WAIT_V(6); PG8_BAR; PG8_MMA(1, 1, At, B1); PG8_BAR;
            }
        }
        if constexpr (ALIGN_EPI) { if (wr == 0) PG8_BAR; }
        if constexpr (!Epi::AFTER_DRAIN) { E(acc, cur, wr, wc, fr, fq); S.done(cur); }
        if (!has_next) break;
#pragma unroll
        for (int a = 0; a < 2; ++a)
#pragma unroll
            for (int b = 0; b < 2; ++b)
#pragma unroll
                for (int m = 0; m < 4; ++m)
#pragma unroll
                    for (int n = 0; n < 2; ++n) acc[a][b][m][n] = (f32x4){0.f, 0.f, 0.f, 0.f};
        cur = nxt; cA = nA; cB = nB; ++ui;
        if constexpr (ALIGN_EPI) { if (wr == 1) PG8_BAR; }
    }
    PG8_WAIT_V(0);
    if constexpr (!ALIGN_EPI) { if (wr == 0) PG8_BAR; }
    PG8_BAR;
    if constexpr (Epi::AFTER_DRAIN) { E.fused(acc, cur, wr, wc, fr, fq, lds, wid, lane); S.done(cur); }
#undef PG8_SA
#undef PG8_SB
#undef PG8_STAGE
#undef PG8_LDA
#undef PG8_LDB
#undef PG8_MMA
#undef PG8_WAIT_V
#undef PG8_WAIT_L
#undef PG8_BAR
#undef PG8_SCHED
}
}

#define LAS __attribute__((address_space(3)))
typedef unsigned short bf16_t;
typedef short bf16x8 __attribute__((ext_vector_type(8)));
typedef short s16x4 __attribute__((ext_vector_type(4)));
typedef float f32x4 __attribute__((ext_vector_type(4)));
typedef float f32x16 __attribute__((ext_vector_type(16)));
typedef unsigned u32x4 __attribute__((ext_vector_type(4)));
typedef unsigned u32x2 __attribute__((ext_vector_type(2)));

constexpr int NWAVES = 8, NTHR = 512;
constexpr int NB = 8, SEQ = 4096, DM = 1024, MTOK = NB * SEQ, PW = 2560, FF = 2816, NLAYER = 2;
constexpr int LDS_BYTES = 163840;
constexpr int LDS_XB_OFF = 159744;
constexpr float EPS = 1e-6f, LOG2E = 1.4426950408889634f, LN2 = 0.6931471805599453f;
constexpr size_t MiB = 1u << 20;
constexpr size_t WS_MOD = 0;
constexpr size_t WS_BAR = 512 * 1024;
constexpr size_t WS_W = 1 * MiB, W_LAYER = 24 * MiB;
constexpr size_t W_IN = 0, W_OUT = 5 * MiB, W_FI = 7 * MiB, W_FO = 18 * MiB;
constexpr size_t WS_H = 49 * MiB;
constexpr size_t WS_Z = 113 * MiB;
constexpr size_t BLK_E = (size_t)14 * MiB;
constexpr size_t ZSEG = (size_t)6 * 4096 * 64;
constexpr size_t UB_OFF_E = 6 * ZSEG;
constexpr size_t MIX_OFF_E = (size_t)10 * MiB;
constexpr size_t MIX_GAP_E = BLK_E - (size_t)4096 * 1024;
constexpr size_t ACT_GAP_E = BLK_E - (size_t)4096 * 2816;
constexpr size_t WS_OBR = 337 * MiB, OBR_STRIDE = 24 * MiB;
constexpr size_t WS_LSE = 433 * MiB;
constexpr size_t WS_X = 440 * MiB;
constexpr size_t WS_END = 504 * MiB;
static_assert(WS_Z + 8 * BLK_E * 2 <= WS_OBR && UB_OFF_E + (size_t)4096 * 256 <= MIX_OFF_E && MIX_OFF_E + (size_t)4096 * 1024 <= BLK_E && (size_t)4096 * 2816 <= BLK_E && W_FO + (size_t)DM * FF * 2 <= W_LAYER, "ws map");

__device__ __forceinline__ float wave_sum(float v) {
#pragma unroll
    for (int o = 1; o < 64; o <<= 1) v += __shfl_xor(v, o);
    return v;
}
__device__ __forceinline__ unsigned f2bf(float f) { unsigned u = __builtin_bit_cast(unsigned, f); return (u + 0x7fffu + ((u >> 16) & 1u)) >> 16; }
__device__ __forceinline__ unsigned pk2(float lo, float hi) { return f2bf(lo) | (f2bf(hi) << 16); }
__device__ __forceinline__ float bf_lo(unsigned w) { return __builtin_bit_cast(float, w << 16); }
__device__ __forceinline__ float bf_hi(unsigned w) { return __builtin_bit_cast(float, w & 0xffff0000u); }
#define LDS_WAIT() asm volatile("s_waitcnt lgkmcnt(0)" ::: "memory")

struct Args {
    const float *x, *c, *w_ada, *b_ada, *norm_mix, *w_in, *norm_a_out, *norm_c_out, *w_pool, *pool_scale, *rpb, *w_out, *norm_ffn, *w_ffn_in, *w_ffn_out, *norm_final;
    float* out; unsigned char* ws; int ph_lo, ph_hi;
};

template <bool SWG>
__device__ __forceinline__ void transpose_item(const float* W, int K, int N, bf16_t* WT, LAS float* scr, int item, int lane) {
    const int nblk = N / 32, kb = item / nblk, nb = item % nblk, k0 = 64 * kb, n0 = 32 * nb;
    int d0 = n0;
    if (SWG) { const int bj = n0 / FF, j = n0 % FF; d0 = 256 * (j / 128) + 128 * bj + (j % 128); }
    float tv[32];
#pragma unroll
    for (int i = 0; i < 32; ++i) tv[i] = W[(size_t)(k0 + 2 * i + (lane >> 5)) * N + n0 + (lane & 31)];
#pragma unroll
    for (int i = 0; i < 32; ++i) scr[(2 * i + (lane >> 5)) * 33 + (lane & 31)] = tv[i];
    LDS_WAIT();
    const int c = lane & 7;
#pragma unroll
    for (int j = 0; j < 4; ++j) { const int n = (lane >> 3) + 8 * j; const LAS float* s = scr + (8 * c) * 33 + n;
        u32x4 o; o.x = pk2(s[0 * 33], s[1 * 33]); o.y = pk2(s[2 * 33], s[3 * 33]); o.z = pk2(s[4 * 33], s[5 * 33]); o.w = pk2(s[6 * 33], s[7 * 33]);
        *(u32x4*)(WT + (size_t)(d0 + n) * K + k0 + 8 * c) = o; }
    LDS_WAIT();
}

__device__ __forceinline__ void phase_p0(const Args& a, LAS unsigned char* lds, int tid, int lane, int wave) {
    float* mod = (float*)(a.ws + WS_MOD);
    for (int item = blockIdx.x; item < 192; item += gridDim.x) {
        LAS float* sc = (LAS float*)lds;
        LAS float* red = (LAS float*)(lds + 32768);
        for (int i = tid; i < 8192; i += NTHR) { const float v = a.c[i]; sc[(i & 1023) * 8 + (i >> 10)] = v / (1.0f + __expf(-v)); }
        __syncthreads();
        const int l = item / 96, cb = item % 96, col = cb * 64 + lane;
        const float* wp = a.w_ada + (size_t)l * DM * 6144 + (size_t)(wave * 128) * 6144 + col;
        float acc0 = 0.f, acc1 = 0.f, acc2 = 0.f, acc3 = 0.f, acc4 = 0.f, acc5 = 0.f, acc6 = 0.f, acc7 = 0.f;
#pragma unroll 16
        for (int k = 0; k < 128; ++k) {
            const float w = wp[(size_t)k * 6144];
            const f32x4 s0 = *(const LAS f32x4*)(sc + (wave * 128 + k) * 8), s1 = *(const LAS f32x4*)(sc + (wave * 128 + k) * 8 + 4);
            acc0 += w * s0[0]; acc1 += w * s0[1]; acc2 += w * s0[2]; acc3 += w * s0[3]; acc4 += w * s1[0]; acc5 += w * s1[1]; acc6 += w * s1[2]; acc7 += w * s1[3];
        }
        red[(wave * 8 + 0) * 64 + lane] = acc0; red[(wave * 8 + 1) * 64 + lane] = acc1; red[(wave * 8 + 2) * 64 + lane] = acc2; red[(wave * 8 + 3) * 64 + lane] = acc3;
        red[(wave * 8 + 4) * 64 + lane] = acc4; red[(wave * 8 + 5) * 64 + lane] = acc5; red[(wave * 8 + 6) * 64 + lane] = acc6; red[(wave * 8 + 7) * 64 + lane] = acc7;
        __syncthreads();
        { const int b = wave; float s = 0.f;
#pragma unroll
          for (int w = 0; w < 8; ++w) s += red[(w * 8 + b) * 64 + lane];
          mod[((size_t)l * NB + b) * 6144 + col] = s + a.b_ada[(size_t)l * 6144 + col]; }
        __syncthreads();
    }
    LAS float* scr = (LAS float*)(lds + wave * 16384);
    const int gw = blockIdx.x * NWAVES + wave, NGW = gridDim.x * NWAVES;
    constexpr int I_IN = (DM / 64) * (PW / 32), I_OUT = (DM / 64) * (DM / 32), I_FI = (DM / 64) * (2 * FF / 32), I_FO = (FF / 64) * (DM / 32), I_L = I_IN + I_OUT + I_FI + I_FO;
    for (int it = gw; it < NLAYER * I_L; it += NGW) {
        const int l = it / I_L; int r = it % I_L;
        unsigned char* wl = a.ws + WS_W + (size_t)l * W_LAYER;
        if (r < I_IN) { transpose_item<false>(a.w_in + (size_t)l * DM * PW, DM, PW, (bf16_t*)(wl + W_IN), scr, r, lane); continue; } r -= I_IN;
        if (r < I_OUT) { transpose_item<false>(a.w_out + (size_t)l * DM * DM, DM, DM, (bf16_t*)(wl + W_OUT), scr, r, lane); continue; } r -= I_OUT;
        if (r < I_FI) { transpose_item<true>(a.w_ffn_in + (size_t)l * DM * 2 * FF, DM, 2 * FF, (bf16_t*)(wl + W_FI), scr, r, lane); continue; } r -= I_FI;
        transpose_item<false>(a.w_ffn_out + (size_t)l * FF * DM, FF, DM, (bf16_t*)(wl + W_FO), scr, r, lane);
    }
}

template <bool FINAL>
__device__ __forceinline__ void norm_rows(const float* X, const float* g, const float* sc, const float* sh, bf16_t* H, float* outF, int gw, int NGW, int lane) {
    for (int cj = 0; 16 * (gw + NGW * (cj >> 3)) < MTOK; ++cj) {
        const int m = 16 * (gw + NGW * (cj >> 3)) + 2 * (cj & 7);
        const f32x4* xr = (const f32x4*)(X + (size_t)m * DM) + lane;
        f32x4 v[2][4]; float s0 = 0.f, s1 = 0.f;
#pragma unroll
        for (int j = 0; j < 4; ++j) { v[0][j] = xr[64 * j]; v[1][j] = xr[256 + 64 * j]; }
#pragma unroll
        for (int j = 0; j < 4; ++j) { s0 += (v[0][j][0] * v[0][j][0] + v[0][j][1] * v[0][j][1]) + (v[0][j][2] * v[0][j][2] + v[0][j][3] * v[0][j][3]);
                                      s1 += (v[1][j][0] * v[1][j][0] + v[1][j][1] * v[1][j][1]) + (v[1][j][2] * v[1][j][2] + v[1][j][3] * v[1][j][3]); }
        const float rstd0 = 1.0f / sqrtf(wave_sum(s0) * (1.0f / DM) + EPS), rstd1 = 1.0f / sqrtf(wave_sum(s1) * (1.0f / DM) + EPS);
        const int b = m >> 12;
#pragma unroll
        for (int j = 0; j < 4; ++j) { const int col = 4 * lane + 256 * j; const f32x4 gv = *(const f32x4*)(g + col);
            f32x4 y0 = v[0][j] * rstd0 * gv, y1 = v[1][j] * rstd1 * gv;
            if (FINAL) { *(f32x4*)(outF + (size_t)m * DM + col) = y0; *(f32x4*)(outF + (size_t)(m + 1) * DM + col) = y1; }
            else { const f32x4 scv = *(const f32x4*)(sc + (size_t)b * 6144 + col) + 1.0f, shv = *(const f32x4*)(sh + (size_t)b * 6144 + col);
                y0 = y0 * scv + shv; y1 = y1 * scv + shv; u32x2 w0, w1; w0.x = pk2(y0[0], y0[1]); w0.y = pk2(y0[2], y0[3]); w1.x = pk2(y1[0], y1[1]); w1.y = pk2(y1[2], y1[3]);
                *(u32x2*)(H + (size_t)m * DM + col) = w0; *(u32x2*)(H + (size_t)(m + 1) * DM + col) = w1; } }
    }
}


template <bool FINAL>
__device__ __forceinline__ void norm_rows_bf(const bf16_t* X, const float* g, const float* sc, const float* sh, bf16_t* H, float* outF, int gw, int NGW, int lane) {
    constexpr int NR = 4;
    u32x4 raw[NR][2], nxt[NR][2];
    static_assert(NR == 4, "row chunking below assumes 4 rows per iteration");
#define NRB_ROW(cj_) (16 * (gw + NGW * ((cj_) >> 2)) + NR * ((cj_) & 3))
    { const int m = NRB_ROW(0); if (m < MTOK) { const u32x4* xr = (const u32x4*)(X + (size_t)m * DM) + lane;
#pragma unroll
        for (int r = 0; r < NR; ++r) { raw[r][0] = xr[128 * r]; raw[r][1] = xr[128 * r + 64]; } } }
    for (int cj = 0; NRB_ROW(cj) < MTOK; ++cj) {
        const int m = NRB_ROW(cj);
        { const int mn = NRB_ROW(cj + 1) < MTOK ? NRB_ROW(cj + 1) : m; const u32x4* xn = (const u32x4*)(X + (size_t)mn * DM) + lane;
#pragma unroll
          for (int r = 0; r < NR; ++r) { nxt[r][0] = xn[128 * r]; nxt[r][1] = xn[128 * r + 64]; } }
        float ss[NR];
#pragma unroll
        for (int r = 0; r < NR; ++r) { ss[r] = 0.f;
#pragma unroll
            for (int j = 0; j < 2; ++j)
#pragma unroll
                for (int e = 0; e < 4; ++e) { const unsigned w = raw[r][j][e]; const float lo = bf_lo(w), hi = bf_hi(w); ss[r] += lo * lo + hi * hi; } }
        float rstd[NR];
#pragma unroll
        for (int r = 0; r < NR; ++r) rstd[r] = 1.0f / sqrtf(wave_sum(ss[r]) * (1.0f / DM) + EPS);
        const int b = m >> 12;
#pragma unroll
        for (int j = 0; j < 2; ++j) { const int col = 8 * lane + 512 * j;
            float gg[8], aa[8], bb[8];
#pragma unroll
            for (int q = 0; q < 2; ++q) { const f32x4 gv = *(const f32x4*)(g + col + 4 * q);
                f32x4 scv = (f32x4){0.f, 0.f, 0.f, 0.f}, shv = scv;
                if (!FINAL) { scv = *(const f32x4*)(sc + (size_t)b * 6144 + col + 4 * q); shv = *(const f32x4*)(sh + (size_t)b * 6144 + col + 4 * q); }
#pragma unroll
                for (int e = 0; e < 4; ++e) { gg[4 * q + e] = gv[e]; aa[4 * q + e] = 1.0f + scv[e]; bb[4 * q + e] = shv[e]; } }
#pragma unroll
            for (int r = 0; r < NR; ++r) {
                float y[8];
#pragma unroll
                for (int e = 0; e < 4; ++e) { const unsigned w = raw[r][j][e]; y[2 * e] = bf_lo(w) * rstd[r] * gg[2 * e]; y[2 * e + 1] = bf_hi(w) * rstd[r] * gg[2 * e + 1]; }
                if (!FINAL) {
#pragma unroll
                    for (int e = 0; e < 8; ++e) y[e] = y[e] * aa[e] + bb[e]; }
                if (FINAL) { float* o = outF + (size_t)(m + r) * DM + col; *(f32x4*)o = (f32x4){y[0], y[1], y[2], y[3]}; *(f32x4*)(o + 4) = (f32x4){y[4], y[5], y[6], y[7]}; }
                else { u32x4 w; w.x = pk2(y[0], y[1]); w.y = pk2(y[2], y[3]); w.z = pk2(y[4], y[5]); w.w = pk2(y[6], y[7]); *(u32x4*)(H + (size_t)(m + r) * DM + col) = w; } } }
#pragma unroll
        for (int r = 0; r < NR; ++r) { raw[r][0] = nxt[r][0]; raw[r][1] = nxt[r][1]; }
    }
#undef NRB_ROW
}
#define LDS_BARRIER() asm volatile("s_waitcnt lgkmcnt(0)\n\ts_barrier" ::: "memory")
__device__ __forceinline__ void pool_phase(const Args& a, int l, LAS unsigned char* lds, int tid, int vb) {
    const bf16_t* UB = (const bf16_t*)(a.ws + WS_Z) + UB_OFF_E; bf16_t* MIX = (bf16_t*)(a.ws + WS_Z) + MIX_OFF_E;
    constexpr int PLP = 528, WTP = 144;
    LAS bf16_t* us = (LAS bf16_t*)lds;
    LAS unsigned char* plb = lds + 40960;
    LAS unsigned char* wt = lds + 40960 + 64 * PLP;
    static_assert(40960 + 64 * PLP + 256 * WTP <= 131072, "pool LDS map");
    const int G = gridDim.x; const bool xa = (G == 256);
    int unit = xa ? (vb & 7) * 64 + (vb >> 3) : vb; const int ustep = xa ? 32 : G, uend = xa ? (vb & 7) * 64 + 64 : 512;
    if (unit >= uend) return;
    const int c = tid & 255, g = c >> 6, th = tid >> 8, hw = 1 << g;
    const int wave = tid >> 6, lane = tid & 63, r = lane & 31, hh = lane >> 5, mg = wave & 3, mt = wave >> 2;
    { const float* wp = a.w_pool + (size_t)l * 4 * 4096;
      for (int i = tid; i < 4 * 4096; i += NTHR) { const int gg = i >> 12, cc = (i >> 6) & 63, dd = i & 63; *(LAS bf16_t*)(wt + (gg * 64 + dd) * WTP + cc * 2) = (bf16_t)f2bf(wp[i]); } }
    const float psc0 = a.pool_scale[l * 256 + mg * 64 + r], psc1 = a.pool_scale[l * 256 + mg * 64 + 32 + r];
    u32x4 pre[5];
#define POOL_LOAD(unit_) do { const int b_ = (unit_) >> 6, t0_ = ((unit_) & 63) * 64; _Pragma("unroll") for (int i_ = 0; i_ < 5; ++i_) { const int q_ = tid + NTHR * i_, rr_ = q_ >> 5, ch_ = q_ & 31, t_ = t0_ - 8 + rr_; \
        pre[i_] = (u32x4){0u, 0u, 0u, 0u}; if (t_ >= 0 && t_ < SEQ) pre[i_] = *(const u32x4*)(UB + (size_t)b_ * BLK_E + (size_t)t_ * 256 + ch_ * 8); } } while (0)
    POOL_LOAD(unit);
#define US(row_) __builtin_bit_cast(float, (unsigned)us[(row_) * 256 + c] << 16)
    for (; unit < uend; unit += ustep) {
        const int b = unit >> 6, t0 = (unit & 63) * 64;
        LDS_BARRIER();
#pragma unroll
        for (int i = 0; i < 5; ++i) { const int q = tid + NTHR * i, rr = q >> 5, ch = q & 31; *(LAS u32x4*)(us + rr * 256 + ch * 8) = pre[i]; }
        LDS_BARRIER();
        if (unit + ustep < uend) POOL_LOAD(unit + ustep);
        { const int tt0 = th * 32; float s = 0.f;
          for (int q = tt0 + 8 - hw; q <= tt0 + 8 + hw - 1; ++q) s += US(q);
          for (int tt = tt0; tt < tt0 + 32; tt += 4) {
              float av[4], bv[4], cv[4], ic[4];
#pragma unroll
              for (int e = 0; e < 4; ++e) { av[e] = US(tt + e + 8 + hw); bv[e] = US(tt + e + 8 - hw); cv[e] = US(tt + e + 8);
                  const int t = t0 + tt + e; int lo = t - hw; if (lo < 0) lo = 0; int hi = t + hw - 1; if (hi > SEQ - 1) hi = SEQ - 1; ic[e] = __builtin_amdgcn_rcpf((float)(hi - lo + 1)); }
#pragma unroll
              for (int e = 0; e < 4; ++e) { *(LAS bf16_t*)(plb + (tt + e) * PLP + c * 2) = (bf16_t)f2bf(s * ic[e] - cv[e]); s += av[e] - bv[e]; } } }
        LDS_BARRIER();
        {
          const LAS unsigned char* ap = plb + (32 * mt + r) * PLP + (mg * 64 + 8 * hh) * 2;
          const LAS unsigned char* bp = wt + (mg * 64 + r) * WTP + (8 * hh) * 2;
          f32x16 y0, y1;
#pragma unroll
          for (int i = 0; i < 16; ++i) { y0[i] = 0.f; y1[i] = 0.f; }
#pragma unroll
          for (int s4 = 0; s4 < 4; ++s4) { const bf16x8 af = *(const LAS bf16x8*)(ap + 32 * s4), b0 = *(const LAS bf16x8*)(bp + 32 * s4), b1 = *(const LAS bf16x8*)(bp + 32 * WTP + 32 * s4);
              y0 = __builtin_amdgcn_mfma_f32_32x32x16_bf16(af, b0, y0, 0, 0, 0); y1 = __builtin_amdgcn_mfma_f32_32x32x16_bf16(af, b1, y1, 0, 0, 0); }
          bf16_t* op = MIX + (size_t)b * BLK_E + (size_t)(t0 + 32 * mt + 4 * hh) * DM + 384 + mg * 64 + r;
#pragma unroll
          for (int i = 0; i < 16; ++i) { const int tk = (i & 3) + 8 * (i >> 2); op[(size_t)tk * DM] = (bf16_t)f2bf(y0[i] * psc0); op[(size_t)tk * DM + 32] = (bf16_t)f2bf(y1[i] * psc1); } }
    }
#undef US
#undef POOL_LOAD
    __syncthreads();
}

constexpr int VP = 144;
constexpr int KT_OFF = 0, VT_OFF = 384 * VP, RPB_OFF = 2 * 384 * VP, QT_OFF = 121856;
static_assert(RPB_OFF + 6 * 15 * 31 * 4 <= QT_OFF && QT_OFF + 256 * VP <= LDS_XB_OFF, "attention LDS map");
struct PassDesc { int mode, b, h, ls, res, i0, r0, sub; };
#define D_KRLO(d_) rstart_of((d_).r0)
#define D_KRHI(d_) (rstart_of((d_).r0 + 3) + 7)
__device__ __forceinline__ int rstart_of(int r) { int s = r - 4; return s < 0 ? 0 : (s > 56 ? 56 : s); }
__device__ __forceinline__ s16x4 vtr(const LAS unsigned char* p) { return __builtin_bit_cast(s16x4, __builtin_amdgcn_ds_read_tr16_b64_v4i16((LAS s16x4*)p)); }
constexpr int NA_UNITS = 48 * 3 * 16, NC_UNITS = 48 * 16;

__device__ __forceinline__ void get_pass(int s, int nA, PassDesc& d, int vb) {
    const int x = vb & 7, li = vb >> 3, G = gridDim.x; const bool xa = (G == 256);
    d.mode = 0; d.b = 0; d.h = 0; d.ls = 0; d.res = 0; d.i0 = 0; d.r0 = 0; d.sub = 0;
    if (s < nA) { const int ia = xa ? li + 32 * s : vb + s * G, bh = (xa ? 6 * x : 0) + ia / 48, u = ia % 48, br = u >> 4, q = u & 15; d.mode = 0; d.b = bh / 6; d.h = bh % 6; d.ls = 2 * br;
        const int cpr = 16 >> d.ls;
        d.res = q / cpr; d.i0 = (q % cpr) * 256; }
    else { const int c = s - nA, ic = xa ? li + 32 * (c >> 1) : vb + (c >> 1) * G, bh = (xa ? 6 * x : 0) + ic / 16, quad = ic & 15; d.mode = 1; d.b = bh / 6; d.h = bh % 6; d.sub = c & 1; d.r0 = 4 * quad; }
}
__device__ __forceinline__ int pass_qtok(const PassDesc& d, int wave, int lane) {
    const int r = lane & 31;
    return d.mode == 0 ? (((d.i0 + 32 * wave + r) << d.ls) + d.res) : ((d.r0 + 2 * (wave >> 2) + (r >> 4)) * 64 + 16 * (wave & 3) + (r & 15));
}
__device__ __forceinline__ void attn_load_kv(const PassDesc& d, const bf16_t* Z, int tid, u32x4 (&kr)[6], u32x4 (&vr)[6]) {
    const bf16_t* Kb = Z + (size_t)d.b * BLK_E + (size_t)(d.mode == 0 ? 1 : 4) * ZSEG + (size_t)d.h * SEQ * 64;
    const int n = SEQ >> d.ls;
    int tq_ = tid; asm volatile("" : "+v"(tq_));
#pragma unroll
    for (int i = 0; i < 6; ++i) { const int q = tq_ + NTHR * i, row = q >> 3, ch = q & 7; int tok;
        if (d.mode == 0) { int j = d.i0 - 64 + row; j = j < 0 ? 0 : (j > n - 1 ? n - 1 : j); tok = (j << d.ls) + d.res; }
        else { const int krhi_ = D_KRHI(d); int kr_ = D_KRLO(d) + 6 * d.sub + (row >> 6); kr_ = kr_ > krhi_ ? krhi_ : kr_; tok = kr_ * 64 + (row & 63); }
        const bf16_t* p = Kb + tok * 64 + ch * 8; kr[i] = *(const u32x4*)p; vr[i] = *(const u32x4*)(p + ZSEG); }
}
__device__ __forceinline__ void attn_load_q(const PassDesc& d, const bf16_t* Z, int wave, int lane, bf16x8 (&qf)[4]) {
    const bf16_t* qp = Z + (size_t)d.b * BLK_E + (size_t)(d.mode == 0 ? 0 : 3) * ZSEG + ((size_t)d.h * SEQ + pass_qtok(d, wave, lane)) * 64 + 8 * (lane >> 5);
#pragma unroll
    for (int s = 0; s < 4; ++s) qf[s] = *(const bf16x8*)(qp + 16 * s);
}
__device__ __forceinline__ void attn_stage(LAS unsigned char* lds, int tid, const u32x4 (&kr)[6], const u32x4 (&vr)[6], const bf16x8 (&qf)[4]) {
    { const int wave_ = tid >> 6, lane_ = tid & 63; LAS unsigned char* qp_ = lds + QT_OFF + (32 * wave_ + (lane_ & 31)) * VP + 16 * (lane_ >> 5);
#pragma unroll
      for (int s_ = 0; s_ < 4; ++s_) *(LAS bf16x8*)(qp_ + 32 * s_) = qf[s_]; }
    int ts_ = tid; asm volatile("" : "+v"(ts_));
#pragma unroll
    for (int i = 0; i < 6; ++i) { const int q = ts_ + NTHR * i, row = q >> 3, ch = q & 7;
        *(LAS u32x4*)(lds + KT_OFF + row * VP + ch * 16) = kr[i]; *(LAS u32x4*)(lds + VT_OFF + row * VP + ch * 16) = vr[i]; }
}

struct AttnLane { int r, hh, n, qi, rq, cq, cstart, rs, kc0; float slope2, mid, hwid; };

template <int MODE, int NT>
__device__ __forceinline__ void attn_step(const PassDesc& d, const AttnLane& L, LAS unsigned char* lds, const LAS float* rpbl, float& m, float& l, f32x16& o0, f32x16& o1, int wave, int lane, int st) {
    typedef float f32x2 __attribute__((ext_vector_type(2)));
    const int r = L.r, hh = L.hh;
    int rowbase[NT], jb[NT], krow[NT];
#pragma unroll
    for (int t = 0; t < NT; ++t) { rowbase[t] = (MODE == 0) ? 32 * (wave + st + t) : 64 * (st + t) + L.kc0; jb[t] = d.i0 - 64 + rowbase[t]; krow[t] = D_KRLO(d) + 6 * d.sub + st + t; }
    f32x16 sa[NT];
#pragma unroll
    for (int t = 0; t < NT; ++t) { const LAS unsigned char* kp = lds + KT_OFF + (rowbase[t] + r) * VP + 16 * hh; const LAS unsigned char* qp = lds + QT_OFF + (32 * wave + r) * VP + 16 * hh; bf16x8 kf[4], qf[4];
#pragma unroll
        for (int s = 0; s < 4; ++s) { kf[s] = *(const LAS bf16x8*)(kp + 32 * s); qf[s] = *(const LAS bf16x8*)(qp + 32 * s); }
#pragma unroll
        for (int i = 0; i < 16; ++i) sa[t][i] = 0.f;
#pragma unroll
        for (int s = 0; s < 4; ++s) sa[t] = __builtin_amdgcn_mfma_f32_32x32x16_bf16(kf[s], qf[s], sa[t], 0, 0, 0);
        __builtin_amdgcn_sched_barrier(0); }
    float mloc = -1e30f;
#pragma unroll
    for (int t = 0; t < NT; ++t) {
        if (MODE == 0) {
            const float rel0 = (float)(jb[t] + 4 * hh - L.qi);
            const f32x2 r2 = (f32x2){rel0, rel0}, m2 = (f32x2){rel0 - L.mid, rel0 - L.mid}, ns2 = (f32x2){-L.slope2, -L.slope2};
#pragma unroll
            for (int i = 0; i < 16; i += 2) { const f32x2 c2 = (f32x2){(float)((i & 3) + 8 * (i >> 2)), (float)(((i + 1) & 3) + 8 * ((i + 1) >> 2))};
                const f32x2 rel = r2 + c2, rc = m2 + c2; const f32x2 ar = (f32x2){__builtin_fabsf(rel.x), __builtin_fabsf(rel.y)};
                const f32x2 s2 = ar * ns2 + (f32x2){sa[t][i], sa[t][i + 1]};
                sa[t][i] = (__builtin_fabsf(rc.x) <= L.hwid) ? s2.x : -1e30f; sa[t][i + 1] = (__builtin_fabsf(rc.y) <= L.hwid) ? s2.y : -1e30f; }
        } else {
            const LAS float* bp = rpbl + (d.h * 15 + (krow[t] - L.rq + 7)) * 31 + (L.kc0 + 4 * hh - L.cq + 15);
            float bias[16];
#pragma unroll
            for (int i = 0; i < 16; ++i) bias[i] = bp[(i & 3) + 8 * (i >> 2)];
            const bool rok = (krow[t] >= L.rs) && (krow[t] <= L.rs + 7); const float cm = rok ? (float)(L.cstart - L.kc0 - 4 * hh) + 7.5f : 1e9f;
#pragma unroll
            for (int i = 0; i < 16; ++i) { const float ci = (float)((i & 3) + 8 * (i >> 2)); const float s = sa[t][i] + bias[i]; sa[t][i] = (__builtin_fabsf(ci - cm) <= 7.5f) ? s : -1e30f; }
        }
#pragma unroll
        for (int i = 0; i < 16; ++i) mloc = fmaxf(mloc, sa[t][i]);
    }
    mloc = fmaxf(mloc, __shfl_xor(mloc, 32));
    const float mn = fmaxf(m, mloc), alpha = __builtin_amdgcn_exp2f(m - mn); m = mn;
    float ps = 0.f;
#pragma unroll
    for (int t = 0; t < NT; ++t)
#pragma unroll
        for (int i = 0; i < 16; ++i) { sa[t][i] = __builtin_amdgcn_exp2f(sa[t][i] - mn); ps += sa[t][i]; }
    l = l * alpha + ps;
#pragma unroll
    for (int i = 0; i < 16; ++i) { o0[i] *= alpha; o1[i] *= alpha; }
#pragma unroll
    for (int t = 0; t < NT; ++t) {
        bf16x8 pb[2];
#pragma unroll
        for (int s2 = 0; s2 < 2; ++s2) { u32x4 w; w.x = pg8::cvt_pk_bf16(sa[t][8 * s2 + 0], sa[t][8 * s2 + 1]); w.y = pg8::cvt_pk_bf16(sa[t][8 * s2 + 2], sa[t][8 * s2 + 3]);
            w.z = pg8::cvt_pk_bf16(sa[t][8 * s2 + 4], sa[t][8 * s2 + 5]); w.w = pg8::cvt_pk_bf16(sa[t][8 * s2 + 6], sa[t][8 * s2 + 7]); pb[s2] = __builtin_bit_cast(bf16x8, w); }
        __builtin_amdgcn_sched_barrier(0);
        const LAS unsigned char* vb = lds + VT_OFF + (rowbase[t] + 4 * hh + ((lane & 15) >> 2)) * VP + (16 * (r >> 4) + 4 * (lane & 3)) * 2;
#pragma unroll
        for (int s2 = 0; s2 < 2; ++s2) {
            const s16x4 a00 = vtr(vb + (16 * s2) * VP), a01 = vtr(vb + (16 * s2 + 8) * VP), a10 = vtr(vb + (16 * s2) * VP + 64), a11 = vtr(vb + (16 * s2 + 8) * VP + 64);
            const bf16x8 A0 = (bf16x8){a00[0], a00[1], a00[2], a00[3], a01[0], a01[1], a01[2], a01[3]}, A1 = (bf16x8){a10[0], a10[1], a10[2], a10[3], a11[0], a11[1], a11[2], a11[3]};
            o0 = __builtin_amdgcn_mfma_f32_32x32x16_bf16(A0, pb[s2], o0, 0, 0, 0);
            o1 = __builtin_amdgcn_mfma_f32_32x32x16_bf16(A1, pb[s2], o1, 0, 0, 0); } }
}

template <int MODE>
__device__ __forceinline__ void attn_compute(const PassDesc& d, LAS unsigned char* lds, const LAS float* rpbl, float& m, float& l, f32x16& o0, f32x16& o1, int wave, int lane) {
    AttnLane L; L.r = lane & 31; L.hh = lane >> 5;
    L.n = SEQ >> d.ls; L.qi = d.i0 + 32 * wave + L.r;
    L.slope2 = exp2f(-8.0f * (float)(d.h + 1) / 6.0f) * LOG2E * (float)(1 << d.ls);
    { const float lo = fmaxf(-64.0f, (float)(-L.qi)), hi = fminf(64.0f, (float)(L.n - 1 - L.qi)); L.mid = 0.5f * (lo + hi); L.hwid = 0.5f * (hi - lo); }
    const int pair = wave >> 2, g = wave & 3; L.rq = d.r0 + 2 * pair + (L.r >> 4); L.cq = 16 * g + (L.r & 15);
    { int cs = L.cq - 8; L.cstart = cs < 0 ? 0 : (cs > 48 ? 48 : cs); }
    L.rs = rstart_of(L.rq); L.kc0 = (g == 0) ? 0 : (g == 1 ? 8 : (g == 2 ? 24 : 32));
    const int wlo = rstart_of(d.r0 + 2 * pair), whi = rstart_of(d.r0 + 2 * pair + 1) + 7;
    constexpr int NST = (MODE == 0) ? 5 : 6;
    int s_lo = NST, s_hi = 0;
#pragma unroll
    for (int st = 0; st < NST; ++st) { bool act;
        if (MODE == 0) { const int jb_ = d.i0 - 64 + 32 * (wave + st); act = !(jb_ + 31 < 0 || jb_ >= L.n); }
        else { const int kr_ = D_KRLO(d) + 6 * d.sub + st; act = !(kr_ > D_KRHI(d) || kr_ < wlo || kr_ > whi); }
        if (act) { s_lo = st < s_lo ? st : s_lo; s_hi = st + 1; } }
#pragma unroll 1
    for (int st = s_lo; st < s_hi; st += 2) {
        if (st + 1 < s_hi) attn_step<MODE, 2>(d, L, lds, rpbl, m, l, o0, o1, wave, lane, st);
        else attn_step<MODE, 1>(d, L, lds, rpbl, m, l, o0, o1, wave, lane, st);
    }
}
__device__ __forceinline__ void attn_final(const Args& a, const PassDesc& d, float m, float l, const f32x16& o0, const f32x16& o1, int wave, int lane) {
    const int hh = lane >> 5, tq = pass_qtok(d, wave, lane);
    const float lt = l + __shfl_xor(l, 32), inv = 1.0f / lt;
    const int slot = d.mode == 0 ? (d.ls >> 1) : 3;
    bf16_t* op = (bf16_t*)(a.ws + WS_OBR + (size_t)slot * OBR_STRIDE) + ((size_t)d.b * SEQ + tq) * 384 + d.h * 64 + 4 * hh;
#pragma unroll
    for (int g4 = 0; g4 < 4; ++g4) {
        u32x2 w0, w1; w0.x = pk2(o0[4 * g4] * inv, o0[4 * g4 + 1] * inv); w0.y = pk2(o0[4 * g4 + 2] * inv, o0[4 * g4 + 3] * inv);
        w1.x = pk2(o1[4 * g4] * inv, o1[4 * g4 + 1] * inv); w1.y = pk2(o1[4 * g4 + 2] * inv, o1[4 * g4 + 3] * inv);
        *(u32x2*)(op + 8 * g4) = w0; *(u32x2*)(op + 32 + 8 * g4) = w1; }
    if (d.mode == 0 && hh == 0) ((float*)(a.ws + WS_LSE))[((size_t)(d.ls >> 1) * MTOK + (size_t)d.b * SEQ + tq) * 6 + d.h] = (m + __log2f(lt)) * LN2;
}

__device__ __forceinline__ void phase_mix(const Args& a, int l, LAS unsigned char* lds, int tid, int lane, int wave, int vb) {
    pool_phase(a, l, lds, tid, vb);
    LAS float* rpbl = (LAS float*)(lds + RPB_OFF);
    for (int i = tid; i < 6 * 15 * 31; i += NTHR) rpbl[i] = a.rpb[(size_t)l * 2790 + i] * LOG2E;
    const bf16_t* Z = (const bf16_t*)(a.ws + WS_Z);
    const int G = gridDim.x, bx = vb;
    const int nA = (G == 256) ? 9 : (bx < NA_UNITS ? (NA_UNITS - bx + G - 1) / G : 0), nC = (G == 256) ? 3 : (bx < NC_UNITS ? (NC_UNITS - bx + G - 1) / G : 0), npass = nA + 2 * nC;
    PassDesc cur, nxt; u32x4 kr[6], vr[6]; bf16x8 qc[4];
    float m = -1e30f, lsum = 0.f; f32x16 o0, o1;
#pragma unroll
    for (int i = 0; i < 16; ++i) { o0[i] = 0.f; o1[i] = 0.f; }
    get_pass(0, nA, cur, vb); nxt = cur;
    if (npass > 0) { attn_load_kv(cur, Z, tid, kr, vr); attn_load_q(cur, Z, wave, lane, qc); }
#pragma unroll 1
    for (int s = 0; s < npass; ++s) {
        LDS_BARRIER();
        attn_stage(lds, tid, kr, vr, qc);
        LDS_BARRIER();
        if (s + 1 < npass) { get_pass(s + 1, nA, nxt, vb); attn_load_kv(nxt, Z, tid, kr, vr); attn_load_q(nxt, Z, wave, lane, qc); }
        if (cur.mode == 0 || cur.sub == 0) { m = -1e30f; lsum = 0.f;
#pragma unroll
            for (int i = 0; i < 16; ++i) { o0[i] = 0.f; o1[i] = 0.f; } }
        if (cur.mode == 0) attn_compute<0>(cur, lds, rpbl, m, lsum, o0, o1, wave, lane);
        else attn_compute<1>(cur, lds, rpbl, m, lsum, o0, o1, wave, lane);
        if (cur.mode == 0 || cur.sub == 1) attn_final(a, cur, m, lsum, o0, o1, wave, lane);
        cur = nxt;
    }
    __syncthreads();
}

__device__ __forceinline__ void phase_combine(const Args& a, int l, int lane, int gw, int NGW) {
    const bf16_t* __restrict__ OB = (const bf16_t*)(a.ws + WS_OBR); const float* __restrict__ LSE = (const float*)(a.ws + WS_LSE); bf16_t* __restrict__ MIX = (bf16_t*)(a.ws + WS_Z) + MIX_OFF_E;
    constexpr size_t OS = OBR_STRIDE / 2; constexpr int NT = 4;
    const bool act = lane < 48; const int ch = act ? 8 * lane : 0, hd = ch >> 6;
    float ga[8], gc[8];
    { const f32x4 a0 = *(const f32x4*)(a.norm_a_out + l * 384 + ch), a1 = *(const f32x4*)(a.norm_a_out + l * 384 + ch + 4), c0 = *(const f32x4*)(a.norm_c_out + l * 384 + ch), c1 = *(const f32x4*)(a.norm_c_out + l * 384 + ch + 4);
#pragma unroll
      for (int e = 0; e < 4; ++e) { ga[e] = a0[e]; ga[4 + e] = a1[e]; gc[e] = c0[e]; gc[4 + e] = c1[e]; } }
    for (int cj = 0; 16 * (gw + NGW * (cj >> 2)) < MTOK; ++cj) {
        const int tok0 = 16 * (gw + NGW * (cj >> 2)) + NT * (cj & 3);
        u32x4 w[NT][4]; float ls[NT][3];
#pragma unroll
        for (int t = 0; t < NT; ++t) { const size_t tok = tok0 + t;
#pragma unroll
            for (int br = 0; br < 4; ++br) w[t][br] = *(const u32x4*)(OB + br * OS + tok * 384 + ch);
#pragma unroll
            for (int br = 0; br < 3; ++br) ls[t][br] = LSE[((size_t)br * MTOK + tok) * 6 + hd]; }
#pragma unroll
        for (int t = 0; t < NT; ++t) { const size_t tok = tok0 + t;
            const float l0 = ls[t][0], l1 = ls[t][1], l2 = ls[t][2];
            const float mx = fmaxf(l0, fmaxf(l1, l2)), e0 = __expf(l0 - mx), e1 = __expf(l1 - mx), e2 = __expf(l2 - mx), inv = 1.0f / (e0 + e1 + e2);
            float va[8], vc[8]; float ssa = 0.f, ssc = 0.f;
#pragma unroll
            for (int e = 0; e < 4; ++e) { const unsigned w0 = w[t][0][e], w1 = w[t][1][e], w2 = w[t][2][e], w3 = w[t][3][e];
                va[2 * e] = (e0 * bf_lo(w0) + e1 * bf_lo(w1) + e2 * bf_lo(w2)) * inv; va[2 * e + 1] = (e0 * bf_hi(w0) + e1 * bf_hi(w1) + e2 * bf_hi(w2)) * inv;
                vc[2 * e] = bf_lo(w3); vc[2 * e + 1] = bf_hi(w3);
                ssa += va[2 * e] * va[2 * e] + va[2 * e + 1] * va[2 * e + 1]; ssc += vc[2 * e] * vc[2 * e] + vc[2 * e + 1] * vc[2 * e + 1]; }
            if (!act) { ssa = 0.f; ssc = 0.f; }
            const float ra = 1.0f / sqrtf(wave_sum(ssa) * (1.0f / 384.0f) + EPS), rc = 1.0f / sqrtf(wave_sum(ssc) * (1.0f / 384.0f) + EPS);
            if (act) { u32x4 oa, oc;
#pragma unroll
                for (int e = 0; e < 4; ++e) { oa[e] = pk2(va[2 * e] * ra * ga[2 * e], va[2 * e + 1] * ra * ga[2 * e + 1]); oc[e] = pk2(vc[2 * e] * rc * gc[2 * e], vc[2 * e + 1] * rc * gc[2 * e + 1]); }
                bf16_t* mp = MIX + (tok >> 12) * BLK_E + (tok & 4095) * DM + ch; *(u32x4*)mp = oa; *(u32x4*)(mp + 640) = oc; } }
    }
}

#define XB_TMO      128
#define XB_XCNT(j)  (256  + 64 * (j))
#define XB_XSUB(j)  (1280 + 64 * (j))
#define XB_XGEN(j)  (2304 + 64 * (j))
#define XB_TOP      3328
#define XB_TOPGEN   3392
#define XCD_BAR_WORDS 3456
#define XB_SPIN_CAP (1u << 18)

__device__ __forceinline__ unsigned xb_ld(unsigned* p)              { return __hip_atomic_load(p, __ATOMIC_RELAXED, __HIP_MEMORY_SCOPE_AGENT); }
__device__ __forceinline__ unsigned xb_add(unsigned* p, unsigned v) { return __hip_atomic_fetch_add(p, v, __ATOMIC_RELAXED, __HIP_MEMORY_SCOPE_AGENT); }
__device__ __forceinline__ unsigned xb_xcc_id() { return (unsigned)__builtin_amdgcn_s_getreg((3 << 11) | 20) & 0xFu; }
#define XB_SPIN(cond, bar) do { unsigned _sp = 0; while (cond) { __builtin_amdgcn_s_sleep(1); \
    if ((++_sp & 255u) == 0u) { if (xb_ld(&(bar)[XB_TMO])) break; if (_sp > XB_SPIN_CAP) { atomicAdd(&(bar)[XB_TMO], 1u); break; } } } } while (0)

struct XcdBarrier {
    unsigned* bar; unsigned x;
    volatile LAS unsigned* st;
};

__device__ __forceinline__ XcdBarrier xcd_barrier_post(unsigned* bar, volatile LAS unsigned* st) {
    XcdBarrier b; b.bar = bar; b.x = xb_xcc_id(); b.st = st;
    if (threadIdx.x == 0) st[2] = xb_add(&bar[XB_XCNT(b.x)], 1u);
    return b;
}
__device__ __forceinline__ void xcd_barrier_complete(unsigned* bar, unsigned x, unsigned& nloc, unsigned& nx, unsigned& reg) {
    const unsigned G = gridDim.x * gridDim.y * gridDim.z;
    unsigned sum, cnt, mine, sp = 0u;
    for (;;) {
        sum = 0u; cnt = 0u; mine = 0u;
#pragma unroll
        for (unsigned j = 0; j < 16; ++j) { const unsigned c = xb_ld(&bar[XB_XCNT(j)]); sum += c; cnt += (c > 0u) ? 1u : 0u; mine = (j == x) ? c : mine; }
        if (sum == G) break;
        __builtin_amdgcn_s_sleep(1);
        if ((++sp & 255u) == 0u) { if (xb_ld(&bar[XB_TMO])) break; if (sp > XB_SPIN_CAP) { atomicAdd(&bar[XB_TMO], 1u); break; } }
    }
    nloc = mine > 0u ? mine : 1u; nx = cnt > 0u ? cnt : 1u;
    { unsigned ok = (sum == G && G == 256u && x < 8u) ? 1u : 0u;
#pragma unroll
      for (unsigned j = 0; j < 16; ++j) { const unsigned c = xb_ld(&bar[XB_XCNT(j)]); if (c != (j < 8u ? 32u : 0u)) ok = 0u; }
      reg = ok; }
}

__device__ __forceinline__ void xcd_barrier(const XcdBarrier& b) {
    asm volatile("s_waitcnt vmcnt(0)" ::: "memory");
    __syncthreads();
    if (threadIdx.x == 0) {
        unsigned* bar = b.bar;
        __builtin_amdgcn_s_waitcnt(0);
        unsigned nloc = b.st[0], nx = b.st[1];
        if (nloc == 0u) { unsigned reg = 0u; xcd_barrier_complete(bar, b.x, nloc, nx, reg); b.st[0] = nloc; b.st[1] = nx; b.st[3] = reg; }
        const unsigned old = xb_add(&bar[XB_XSUB(b.x)], 1u);
        const unsigned gen = old / nloc;
        if (old + 1u == (gen + 1u) * nloc) {
            __builtin_amdgcn_fence(__ATOMIC_RELEASE, "agent");
            asm volatile("s_waitcnt vmcnt(0)" ::: "memory");
            const unsigned og = xb_add(&bar[XB_TOP], 1u);
            const unsigned tg = og / nx;
            if (og + 1u == (tg + 1u) * nx) xb_add(&bar[XB_TOPGEN], 1u);
            else XB_SPIN(xb_ld(&bar[XB_TOPGEN]) == tg, bar);
            __builtin_amdgcn_fence(__ATOMIC_ACQUIRE, "agent");
            xb_add(&bar[XB_XGEN(b.x)], 1u);
            asm volatile("s_waitcnt vmcnt(0)" ::: "memory");
        } else {
            XB_SPIN(xb_ld(&bar[XB_XGEN(b.x)]) == gen, bar);
            __builtin_amdgcn_fence(__ATOMIC_ACQUIRE, "agent");
            asm volatile("s_waitcnt vmcnt(0)" ::: "memory");
        }
    }
    __syncthreads();
}

__device__ __forceinline__ void xcd_barrier_local(const XcdBarrier& b) {
    asm volatile("s_waitcnt vmcnt(0)" ::: "memory");
    __syncthreads();
    if (threadIdx.x == 0) {
        unsigned* bar = b.bar;
        __builtin_amdgcn_s_waitcnt(0);
        const unsigned nloc = b.st[0];
        const unsigned old = xb_add(&bar[XB_XSUB(b.x)], 1u);
        const unsigned gen = old / nloc;
        if (old + 1u == (gen + 1u) * nloc) xb_add(&bar[XB_XGEN(b.x)], 1u);
        else XB_SPIN(xb_ld(&bar[XB_XGEN(b.x)]) == gen, bar);
        __builtin_amdgcn_fence(__ATOMIC_ACQUIRE, "agent");
        asm volatile("s_waitcnt vmcnt(0)" ::: "memory");
    }
    __syncthreads();
}
#ifndef PH_MASK
#define PH_MASK 0x3ff
#endif
#ifndef REP_MASK
#define REP_MASK 0
#endif
constexpr unsigned REPM = REP_MASK;
constexpr unsigned PHM = PH_MASK;
constexpr int N_PHASES = 18;
__global__ void __launch_bounds__(NTHR, 2) fwd_mega(Args a) {
    extern __shared__ __attribute__((aligned(16))) unsigned char lds_raw[];
    LAS unsigned char* lds = (LAS unsigned char*)lds_raw;
    const int n_it = (a.ph_hi - a.ph_lo) * (REPM ? 2 : 1);
    volatile LAS unsigned* xst = (volatile LAS unsigned*)(lds + LDS_XB_OFF);
    if (threadIdx.x < 4) xst[threadIdx.x] = 0u;
    __syncthreads();
    if (a.ph_lo < 0) cg::this_grid().sync();
    const XcdBarrier xbar = xcd_barrier_post((unsigned*)(a.ws + WS_BAR), xst);
    for (int it = 0; it < n_it; ++it) {
        const int ph = a.ph_lo + (REPM ? (it >> 1) : it);
        if (REPM && (it & 1) && !((ph >= 1 && ph < N_PHASES - 1 && ((REPM >> ((ph - 1) & 7)) & 1u)) || (ph == 0 && (REPM & 0x100u)))) continue;
        const bool dummy = REPM && (it & 1);
        if (it == 1) xcd_barrier(xbar);
        const bool regular = it >= 1 && __builtin_amdgcn_readfirstlane((int)xst[3]) != 0;
        if (it > 1) { if (regular) xcd_barrier_local(xbar); else xcd_barrier(xbar); }
        const int vb = regular ? __builtin_amdgcn_readfirstlane((int)(xst[2] * 8u + xbar.x)) : (int)blockIdx.x;
#ifdef DEPHASE_TICKS
        if (regular && it == 1 && (xbar.x & DEPHASE_MASK)) { const unsigned long long t0 = __builtin_amdgcn_s_memrealtime(), tw = (unsigned long long)DEPHASE_TICKS * (xbar.x & DEPHASE_MASK); while (__builtin_amdgcn_s_memrealtime() - t0 < tw) __builtin_amdgcn_s_sleep(32); }
#endif
        int tid = threadIdx.x; asm volatile("" : "+v"(tid));
        const int lane = tid & 63, wave = __builtin_amdgcn_readfirstlane(tid >> 6);
        const int NGW = gridDim.x * NWAVES, gw = (gridDim.x == 256) ? 256 * (vb & 7) + 8 * (vb >> 3) + wave : vb * NWAVES + wave;
        if (ph == 0) { if (PHM & 1) phase_p0(a, lds, tid, lane, wave); continue; }
        if (ph == N_PHASES - 1) { if (PHM & 2) norm_rows_bf<true>((const bf16_t*)(a.ws + WS_X), a.norm_final, nullptr, nullptr, nullptr, a.out, gw, NGW, lane); continue; }
        const int l = (ph - 1) >> 3, k = (ph - 1) & 7;
        const float* modl = (const float*)(a.ws + WS_MOD) + (size_t)l * NB * 6144;
        bf16_t* H = (bf16_t*)(a.ws + WS_H); bf16_t* Z = (bf16_t*)(a.ws + WS_Z); bf16_t* MIX = (bf16_t*)(a.ws + WS_Z) + MIX_OFF_E; bf16_t* ACT = (bf16_t*)(a.ws + WS_Z);
        const unsigned char* wl = a.ws + WS_W + (size_t)l * W_LAYER;
        bf16_t* XS = (bf16_t*)(a.ws + WS_X);
        if (k == 0) { if (PHM & 4) { if (l == 0) norm_rows<false>(a.x, a.norm_mix + l * DM, modl + 1024, modl, H, nullptr, gw, NGW, lane);
                                         else norm_rows_bf<false>(XS, a.norm_mix + l * DM, modl + 1024, modl, H, nullptr, gw, NGW, lane); } }
        else if (k == 1) { if (PHM & 8) { pg8::Gemm g{H, (const bf16_t*)(wl + W_IN), MTOK, PW, DM, 0}; pg8::StaticOrder S; S.init(MTOK, PW, gridDim.x, vb);
            pg8::EpiZH E{Z}; pg8::gemm_phase<pg8::EpiZH, pg8::StaticOrder, true, true>(lds, g, S, E, tid); } }
        else if (k == 2) { if (PHM & 16) phase_mix(a, l, lds, tid, lane, wave, vb); }
        else if (k == 3) { if (PHM & 32) phase_combine(a, l, lane, gw, NGW); }
        else if (k == 4) { if (PHM & 64) { pg8::Gemm g{MIX, (const bf16_t*)(wl + W_OUT), MTOK, DM, DM, MIX_GAP_E}; pg8::StaticOrder S; S.init(MTOK, DM, gridDim.x, vb);
            if (l == 0) { pg8::EpiResid<true> E{a.x, dummy ? (bf16_t*)(a.ws + 337 * MiB) : XS, modl + 2048}; pg8::gemm_phase<pg8::EpiResid<true>, pg8::StaticOrder, true, true>(lds, g, S, E, tid); }
            else { pg8::EpiResid<false> E{XS, XS, modl + 2048}; pg8::gemm_phase<pg8::EpiResid<false>, pg8::StaticOrder, true, true>(lds, g, S, E, tid); } } }
        else if (k == 5) { if (PHM & 128) norm_rows_bf<false>(XS, a.norm_ffn + l * DM, modl + 4096, modl + 3072, H, nullptr, gw, NGW, lane); }
        else if (k == 6) { if (PHM & 256) { pg8::Gemm g{H, (const bf16_t*)(wl + W_FI), MTOK, 2 * FF, DM, 0}; pg8::StaticOrder S; S.init(MTOK, 2 * FF, gridDim.x, vb);
            pg8::EpiSwiGLU E{ACT, FF, ACT_GAP_E}; pg8::gemm_phase<pg8::EpiSwiGLU, pg8::StaticOrder, true, true>(lds, g, S, E, tid); } }
        else { if (PHM & 512) { pg8::Gemm g{ACT, (const bf16_t*)(wl + W_FO), MTOK, DM, FF, ACT_GAP_E}; pg8::StaticOrder S; S.init(MTOK, DM, gridDim.x, vb);
            pg8::EpiResid<false> E{XS, dummy ? (bf16_t*)(a.ws + 337 * MiB) : XS, modl + 5120}; pg8::gemm_phase<pg8::EpiResid<false>, pg8::StaticOrder, true, true>(lds, g, S, E, tid); } }
    }
}

extern "C" void kernel_launch(void* const* d_in, const int* in_sizes, int n_in, void* d_out, int out_size, void* d_ws, size_t ws_size, hipStream_t stream) {
    static int grid = 0;
    if (grid == 0) {
        if (n_in != 16 || out_size != MTOK * DM || ws_size < WS_END) { fprintf(stderr, "kernel_launch: unexpected shapes (n_in %d out %d ws %zu)\n", n_in, out_size, ws_size); grid = -1; return; }
        int dev = 0, cus = 0, per_cu = 0;
        hipGetDevice(&dev); hipDeviceGetAttribute(&cus, hipDeviceAttributeMultiprocessorCount, dev);
        if (hipFuncSetAttribute((const void*)fwd_mega, hipFuncAttributeMaxDynamicSharedMemorySize, LDS_BYTES) != hipSuccess) { fprintf(stderr, "kernel_launch: hipFuncSetAttribute failed\n"); grid = -1; return; }
        if (hipOccupancyMaxActiveBlocksPerMultiprocessor(&per_cu, (const void*)fwd_mega, NTHR, LDS_BYTES) != hipSuccess || per_cu < 1) { fprintf(stderr, "kernel_launch: occupancy query says %d\n", per_cu); per_cu = 1; }
        (void)hipGetLastError();
        grid = cus * (per_cu > 1 ? 1 : per_cu);
    }
    if (grid < 0) return;
    if (hipMemsetAsync((char*)d_ws + WS_BAR, 0, 16384, stream) != hipSuccess) { fprintf(stderr, "kernel_launch: memset of the barrier words failed\n"); return; }
    Args a{};
    a.x = (const float*)d_in[0]; a.c = (const float*)d_in[1]; a.w_ada = (const float*)d_in[2]; a.b_ada = (const float*)d_in[3]; a.norm_mix = (const float*)d_in[4];
    a.w_in = (const float*)d_in[5]; a.norm_a_out = (const float*)d_in[6]; a.norm_c_out = (const float*)d_in[7]; a.w_pool = (const float*)d_in[8]; a.pool_scale = (const float*)d_in[9];
    a.rpb = (const float*)d_in[10]; a.w_out = (const float*)d_in[11]; a.norm_ffn = (const float*)d_in[12]; a.w_ffn_in = (const float*)d_in[13]; a.w_ffn_out = (const float*)d_in[14];
    a.norm_final = (const float*)d_in[15]; a.out = (float*)d_out; a.ws = (unsigned char*)d_ws;
#if MK_PER_PHASE
    for (int ph = 0; ph < N_PHASES; ++ph) { a.ph_lo = ph; a.ph_hi = ph + 1; void* args[] = {&a};
        hipError_t e = hipLaunchCooperativeKernel((const void*)fwd_mega, dim3(grid), dim3(NTHR), args, LDS_BYTES, stream);
        if (e != hipSuccess) { fprintf(stderr, "launch %d failed: %s\n", ph, hipGetErrorString(e)); break; } }
#else
    a.ph_lo = 0; a.ph_hi = N_PHASES; void* args[] = {&a};
    hipError_t e = hipLaunchCooperativeKernel((const void*)fwd_mega, dim3(grid), dim3(NTHR), args, LDS_BYTES, stream);
    if (e != hipSuccess) fprintf(stderr, "cooperative launch failed: %s (grid %d)\n", hipGetErrorString(e), grid);
#endif
}
```

```cpp
#include <hip/hip_runtime.h>
#include <hip/hip_cooperative_groups.h>
#include <cstdio>
#include <cstdint>
namespace cg = cooperative_groups;
#ifndef MK_PER_PHASE
#define MK_PER_PHASE 0
#endif
namespace pg8 {
#define PG8_LAS __attribute__((address_space(3)))
typedef unsigned short bf16_t;
typedef short bf16x8 __attribute__((ext_vector_type(8)));
typedef float f32x4 __attribute__((ext_vector_type(4)));
typedef unsigned u32x4 __attribute__((ext_vector_type(4)));
constexpr int BM = 256, BK = 64, HALF = 128, HTB = HALF * BK * 2  , STAGE_BYTES = 8 * HTB, NXCD = 8, WGM = 8;

__host__ __device__ __forceinline__ int lds_byte(int r, int c) { const int st = (r >> 4) * 2 + (c >> 5), rr = r & 15, cc = c & 31, ob = rr * 64 + cc * 2; return st * 1024 + (ob ^ (((ob >> 9) & 1) << 5)); }
__host__ __device__ __forceinline__ void stage_rc(int b, int& R, int& C) { const int st = b / 1024, sb = b % 1024, swz = sb ^ (((sb >> 9) & 1) << 5); R = (st >> 1) * 16 + swz / 64; C = (st & 1) * 32 + (swz % 64) / 2; }
__host__ __device__ __forceinline__ int perm32(int rho) { const int n = rho >> 4, i = rho & 15; return 8 * (i >> 2) + 4 * n + (i & 3); }

struct Unit { int pm, pn; };
struct Gemm { const bf16_t* A; const bf16_t* Bt; int M, N, K; size_t agap; };

struct StaticOrder {
    int nM, nN, nwg, G, c;
    __host__ __device__ void init(int M, int N, int G_, int c_) { nM = M / BM; nN = N / BM; nwg = nM * nN; G = G_; c = c_; }
    __host__ __device__ bool next(int i, Unit& u) const {
        const long L = (long)i * G + c; if (L >= nwg) return false;
        int wgid = (int)L; { const int q = nwg / NXCD, r = nwg % NXCD, xcd = wgid % NXCD, off = wgid / NXCD; wgid = (xcd < r ? xcd * (q + 1) : r * (q + 1) + (xcd - r) * q) + off; }
        const int nig = WGM * nN, gid = wgid / nig, fm = gid * WGM, gsz = (nM - fm) < WGM ? (nM - fm) : WGM;
        u.pm = fm + ((wgid % nig) % gsz); u.pn = (wgid % nig) / gsz; return true;
    }
    __device__ __forceinline__ void a_ready(const Unit&) const {}
    __device__ __forceinline__ void done(const Unit&) const {}
};

__device__ __forceinline__ unsigned cvt_pk_bf16(float lo, float hi) { unsigned r; asm volatile("v_cvt_pk_bf16_f32 %0, %1, %2" : "=v"(r) : "v"(lo), "v"(hi)); return r; }
typedef float f32x2 __attribute__((ext_vector_type(2)));
typedef unsigned u32x2 __attribute__((ext_vector_type(2)));
__device__ __forceinline__ float silu_f(float g) { return g * __builtin_amdgcn_rcpf(1.0f + __builtin_amdgcn_exp2f(-1.4426950408889634f * g)); }
struct EpiZH {
    static constexpr bool PERM = true, AFTER_DRAIN = false;
    static constexpr size_t SEG = (size_t)6 * 4096 * 64, BLK = (size_t)14 << 20;
    bf16_t* Zh;
    __device__ __forceinline__ void operator()(const f32x4 (&acc)[2][2][4][2], const Unit& u, int wr, int wc, int fr, int fq) const {
        const int m0 = u.pm * BM, b = m0 >> 12, t0 = (m0 & 4095) + wr * 64 + fr;
#pragma unroll
        for (int bj = 0; bj < 2; ++bj) {
            const int colw = u.pn * BM + bj * HALF + wc * 32;
            bf16_t* dst; int ld; float qs = 1.0f;
            if (colw >= 1152 && colw < 1408) { dst = Zh + (size_t)b * BLK + 6 * SEG + (colw - 1152) + 8 * fq; ld = 256; }
            else { const int cc = colw < 1152 ? colw : colw - 1408, seg = (colw < 1152 ? 0 : 3) + cc / 384, rem = cc % 384, h = rem >> 6, d0 = rem & 63;
                   dst = Zh + (size_t)b * BLK + (size_t)seg * SEG + (size_t)h * 4096 * 64 + d0 + 8 * fq; ld = 64; qs = (seg == 0 || seg == 3) ? 0.125f * 1.4426950408889634f : 1.0f; }
#pragma unroll
            for (int ai = 0; ai < 2; ++ai)
#pragma unroll
                for (int m = 0; m < 4; ++m) { const f32x4 v0 = acc[ai][bj][m][0] * qs, v1 = acc[ai][bj][m][1] * qs;
                    u32x4 w; w.x = cvt_pk_bf16(v0[0], v0[1]); w.y = cvt_pk_bf16(v0[2], v0[3]); w.z = cvt_pk_bf16(v1[0], v1[1]); w.w = cvt_pk_bf16(v1[2], v1[3]);
                    *(u32x4*)(dst + (size_t)(t0 + ai * HALF + m * 16) * ld) = w; } }
    }
};
struct EpiSwiGLU {
    static constexpr bool PERM = true, AFTER_DRAIN = false;
    bf16_t* O; int ldc; size_t ogap;
    __device__ __forceinline__ void operator()(const f32x4 (&acc)[2][2][4][2], const Unit& u, int wr, int wc, int fr, int fq) const {
        const int row0 = u.pm * BM + wr * 64 + fr, col0 = u.pn * HALF + wc * 32 + 8 * fq;
#pragma unroll
        for (int ai = 0; ai < 2; ++ai)
#pragma unroll
            for (int m = 0; m < 4; ++m) { bf16_t* rowp = O + (size_t)(row0 + ai * HALF + m * 16) * ldc + (size_t)(u.pm >> 4) * ogap + col0;
                const f32x4 g0 = acc[ai][0][m][0], g1 = acc[ai][0][m][1], u0 = acc[ai][1][m][0], u1 = acc[ai][1][m][1];
                u32x4 w; w.x = cvt_pk_bf16(silu_f(g0[0]) * u0[0], silu_f(g0[1]) * u0[1]); w.y = cvt_pk_bf16(silu_f(g0[2]) * u0[2], silu_f(g0[3]) * u0[3]);
                w.z = cvt_pk_bf16(silu_f(g1[0]) * u1[0], silu_f(g1[1]) * u1[1]); w.w = cvt_pk_bf16(silu_f(g1[2]) * u1[2], silu_f(g1[3]) * u1[3]);
                *(u32x4*)rowp = w; }
    }
};
template <bool BASE_F32>
struct EpiResid {
    static constexpr bool PERM = true, AFTER_DRAIN = false;
    const void* base; bf16_t* out; const float* gate;
    __device__ __forceinline__ void operator()(const f32x4 (&acc)[2][2][4][2], const Unit& u, int wr, int wc, int fr, int fq) const {
        const int row0 = u.pm * BM + wr * 64 + fr, col0 = u.pn * BM + wc * 32 + 8 * fq;
        const float* gp = gate + (size_t)(u.pm >> 4) * 6144 + col0;
        f32x4 gv[2][2];
#pragma unroll
        for (int bj = 0; bj < 2; ++bj)
#pragma unroll
            for (int n = 0; n < 2; ++n) gv[bj][n] = *(const f32x4*)(gp + bj * HALF + n * 4);
        constexpr int MB = BASE_F32 ? 1 : 4;
#pragma unroll
        for (int ai = 0; ai < 2; ++ai)
#pragma unroll
            for (int mb = 0; mb < 4; mb += MB) {
                f32x4 bl[MB][2][2]; u32x4 bw[MB][2];
#pragma unroll
                for (int mi = 0; mi < MB; ++mi) { const size_t off = (size_t)(row0 + ai * HALF + (mb + mi) * 16) * 1024 + col0;
#pragma unroll
                    for (int bj = 0; bj < 2; ++bj) {
                        if (BASE_F32) { bl[mi][bj][0] = *(const f32x4*)((const float*)base + off + bj * HALF); bl[mi][bj][1] = *(const f32x4*)((const float*)base + off + bj * HALF + 4); }
                        else bw[mi][bj] = *(const u32x4*)((const bf16_t*)base + off + bj * HALF); } }
#pragma unroll
                for (int mi = 0; mi < MB; ++mi) { const int m = mb + mi; const size_t off = (size_t)(row0 + ai * HALF + m * 16) * 1024 + col0;
#pragma unroll
                    for (int bj = 0; bj < 2; ++bj) { f32x4 b0, b1;
                        if (BASE_F32) { b0 = bl[mi][bj][0]; b1 = bl[mi][bj][1]; }
                        else { const u32x4 w = bw[mi][bj];
                               b0 = (f32x4){__builtin_bit_cast(float, w.x << 16), __builtin_bit_cast(float, w.x & 0xffff0000u), __builtin_bit_cast(float, w.y << 16), __builtin_bit_cast(float, w.y & 0xffff0000u)};
                               b1 = (f32x4){__builtin_bit_cast(float, w.z << 16), __builtin_bit_cast(float, w.z & 0xffff0000u), __builtin_bit_cast(float, w.w << 16), __builtin_bit_cast(float, w.w & 0xffff0000u)}; }
                        const f32x4 o0 = b0 + gv[bj][0] * acc[ai][bj][m][0], o1 = b1 + gv[bj][1] * acc[ai][bj][m][1];
                        u32x4 r; r.x = cvt_pk_bf16(o0[0], o0[1]); r.y = cvt_pk_bf16(o0[2], o0[3]); r.z = cvt_pk_bf16(o1[0], o1[1]); r.w = cvt_pk_bf16(o1[2], o1[3]);
                        *(u32x4*)(out + off + bj * HALF) = r; } }
                asm volatile("" ::: "memory"); }
    }
};
template <class Epi, class Sched, bool ALIGN_EPI = false, bool SP2 = false>
__device__ __forceinline__ void gemm_phase(PG8_LAS unsigned char* lds, const Gemm g, const Sched& S, const Epi& E, const int tid) {
    const int wid = __builtin_amdgcn_readfirstlane(tid >> 6), lane = tid & 63, wr = wid >> 2, wc = wid & 3, fr = lane & 15, fq = lane >> 4;
    const int K = g.K, nt = K / BK;
    unsigned voffA[2], voffB[2];
#pragma unroll
    for (int i = 0; i < 2; ++i) { int R, C; stage_rc(tid * 16 + i * 8192, R, C); const int Rb = Epi::PERM ? ((R & ~31) + perm32(R & 31)) : R;
        voffA[i] = (unsigned)(R * K + C) * 2u; voffB[i] = (unsigned)(Rb * K + C) * 2u; }
    const size_t kstep = (size_t)(BK * 2);
    const size_t hstep = (size_t)HALF * K * 2;
    const size_t tstep = 2 * hstep;
    const unsigned ldsw = (unsigned)wid * 1024u;
    const int aoff = lds_byte(wr * 64 + fr, fq * 8), boff = lds_byte(wc * 32 + fr, fq * 8);
#define PG8_SA(b, h) (((b) * 2 + (h)) * HTB)
#define PG8_SB(b, h) ((4 + (b) * 2 + (h)) * HTB)
#define PG8_STAGE(bufoff, gbase, voff) do { _Pragma("unroll") for (int _i = 0; _i < 2; ++_i) \
        __builtin_amdgcn_global_load_lds((const unsigned*)((const char*)(gbase) + (voff)[_i]), (PG8_LAS unsigned*)(lds + (bufoff) + ldsw + _i * 8192), 16, 0, 0); } while (0)
#define PG8_LDA(dst, b, h) do { _Pragma("unroll") for (int m = 0; m < 4; ++m) _Pragma("unroll") for (int k = 0; k < 2; ++k) dst[m][k] = *(const PG8_LAS bf16x8*)(lds + PG8_SA(b, h) + aoff + m * 2048 + k * 1024); } while (0)
#define PG8_LDB(dst, b, h) do { _Pragma("unroll") for (int n = 0; n < 2; ++n) _Pragma("unroll") for (int k = 0; k < 2; ++k) dst[n][k] = *(const PG8_LAS bf16x8*)(lds + PG8_SB(b, h) + boff + n * 2048 + k * 1024); } while (0)
#define PG8_MMA(ai, bj, At, Bt) do { __builtin_amdgcn_s_setprio(1); _Pragma("unroll") for (int m = 0; m < 4; ++m) _Pragma("unroll") for (int n = 0; n < 2; ++n) _Pragma("unroll") for (int k = 0; k < 2; ++k) \
        acc[ai][bj][m][n] = __builtin_amdgcn_mfma_f32_16x16x32_bf16(Bt[n][k], At[m][k], acc[ai][bj][m][n], 0, 0, 0); __builtin_amdgcn_s_setprio(0); } while (0)
#define PG8_WAIT_V(n) asm volatile("s_waitcnt vmcnt(" #n ")" ::: "memory")
#define PG8_WAIT_L(n) asm volatile("s_waitcnt lgkmcnt(" #n ")" ::: "memory")
#define PG8_BAR __builtin_amdgcn_s_barrier()
#define PG8_SCHED __builtin_amdgcn_sched_barrier(0)
    Unit cur, nxt; int ui = 0;
    if (!S.next(0, cur)) return;
    f32x4 acc[2][2][4][2];
#pragma unroll
    for (int a = 0; a < 2; ++a)
#pragma unroll
        for (int b = 0; b < 2; ++b)
#pragma unroll
            for (int m = 0; m < 4; ++m)
#pragma unroll
                for (int n = 0; n < 2; ++n) acc[a][b][m][n] = (f32x4){0.f, 0.f, 0.f, 0.f};
    bf16x8 At[4][2], B0[2][2], B1[2][2];
    const char* cA = (const char*)g.A + (size_t)cur.pm * tstep + (size_t)(cur.pm >> 4) * g.agap * 2; const char* cB = (const char*)g.Bt + (size_t)cur.pn * tstep;
    S.a_ready(cur);
    if constexpr (SP2) {
        PG8_STAGE(PG8_SB(0, 0), cB, voffB); PG8_STAGE(PG8_SB(0, 1), cB + hstep, voffB); PG8_STAGE(PG8_SA(0, 0), cA, voffA); PG8_STAGE(PG8_SA(0, 1), cA + hstep, voffA);
        if (wr == 1) PG8_BAR;
        PG8_WAIT_V(2); PG8_BAR;
        PG8_STAGE(PG8_SB(1, 0), cB + kstep, voffB); PG8_STAGE(PG8_SA(1, 0), cA + kstep, voffA); PG8_STAGE(PG8_SB(1, 1), cB + hstep + kstep, voffB);
        PG8_WAIT_V(6); PG8_BAR;
    } else {
        PG8_STAGE(PG8_SB(0, 0), cB, voffB); PG8_STAGE(PG8_SA(0, 0), cA, voffA); PG8_STAGE(PG8_SB(0, 1), cB + hstep, voffB); PG8_STAGE(PG8_SA(0, 1), cA + hstep, voffA);
        if (wr == 1) PG8_BAR;
        PG8_WAIT_V(4); PG8_BAR;
        PG8_STAGE(PG8_SB(1, 0), cB + kstep, voffB); PG8_STAGE(PG8_SA(1, 0), cA + kstep, voffA); PG8_STAGE(PG8_SB(1, 1), cB + hstep + kstep, voffB);
        PG8_WAIT_V(6); PG8_BAR;
    }
    for (;;) {
        const bool has_next = S.next(ui + 1, nxt);
        const char* nA = has_next ? (const char*)g.A + (size_t)nxt.pm * tstep + (size_t)(nxt.pm >> 4) * g.agap * 2 : cA; const char* nB = has_next ? (const char*)g.Bt + (size_t)nxt.pn * tstep : cB;
        for (int t = 0; t < nt; t += 2) {
            const bool last = (t == nt - 2);
            const char* a1 = cA + (size_t)(t + 1) * kstep;
            const char* a2 = last ? nA : cA + (size_t)(t + 2) * kstep; const char* b2 = last ? nB : cB + (size_t)(t + 2) * kstep;
            const char* a3 = a2 + kstep; const char* b3 = b2 + kstep;
            if (last && has_next) S.a_ready(nxt);
            if constexpr (SP2) {
            PG8_LDB(B0, 0, 0); PG8_LDB(B1, 0, 1); PG8_SCHED; PG8_LDA(At, 0, 0); PG8_STAGE(PG8_SA(1, 1), a1 + hstep, voffA);
            PG8_WAIT_V(8); PG8_WAIT_L(0); PG8_BAR; PG8_MMA(0, 0, At, B0); PG8_MMA(0, 1, At, B1); PG8_BAR; PG8_SCHED;
            PG8_LDA(At, 0, 1); PG8_STAGE(PG8_SB(0, 0), b2, voffB); PG8_STAGE(PG8_SB(0, 1), b2 + hstep, voffB); PG8_STAGE(PG8_SA(0, 0), a2, voffA);
            PG8_WAIT_V(8); PG8_WAIT_L(0); PG8_BAR; PG8_MMA(1, 0, At, B0); PG8_MMA(1, 1, At, B1); PG8_BAR; PG8_SCHED;
            PG8_LDB(B0, 1, 0); PG8_LDB(B1, 1, 1); PG8_SCHED; PG8_LDA(At, 1, 0); PG8_STAGE(PG8_SA(0, 1), a2 + hstep, voffA);
            PG8_WAIT_V(8); PG8_WAIT_L(0); PG8_BAR; PG8_MMA(0, 0, At, B0); PG8_MMA(0, 1, At, B1); PG8_BAR; PG8_SCHED;
            PG8_LDA(At, 1, 1); PG8_STAGE(PG8_SB(1, 0), b3, voffB); PG8_STAGE(PG8_SB(1, 1), b3 + hstep, voffB); PG8_STAGE(PG8_SA(1, 0), a3, voffA);
            PG8_WAIT_V(8); PG8_WAIT_L(0); PG8_BAR; PG8_MMA(1, 0, At, B0); PG8_MMA(1, 1, At, B1); PG8_BAR; PG8_SCHED;
            } else {
            PG8_LDB(B0, 0, 0); PG8_SCHED; PG8_LDA(At, 0, 0); PG8_STAGE(PG8_SA(1, 1), a1 + hstep, voffA);
            PG8_WAIT_L(8); PG8_BAR; PG8_WAIT_L(0); PG8_MMA(0, 0, At, B0); PG8_BAR; PG8_SCHED;
            PG8_LDB(B1, 0, 1); PG8_STAGE(PG8_SB(0, 0), b2, voffB);
            PG8_BAR; PG8_WAIT_L(0); PG8_MMA(0, 1, At, B1); PG8_BAR;
            PG8_LDA(At, 0, 1); PG8_STAGE(PG8_SA(0, 0), a2, voffA);
            PG8_BAR; PG8_WAIT_L(0); PG8_MMA(1, 0, At, B0); PG8_BAR; PG8_SCHED;
            PG8_STAGE(PG8_SB(0, 1), b2 + hstep, voffB);
            PG8_WAIT_V(6); PG8_BAR; PG8_MMA(1, 1, At, B1); PG8_BAR;
            PG8_LDB(B0, 1, 0); PG8_SCHED; PG8_LDA(At, 1, 0); PG8_STAGE(PG8_SA(0, 1), a2 + hstep, voffA);
            PG8_WAIT_L(8); PG8_BAR; PG8_WAIT_L(0); PG8_MMA(0, 0, At, B0); PG8_BAR; PG8_SCHED;
            PG8_LDB(B1, 1, 1); PG8_STAGE(PG8_SB(1, 0), b3, voffB);
            PG8_BAR; PG8_WAIT_L(0); PG8_MMA(0, 1, At, B1); PG8_BAR;
            PG8_LDA(At, 1, 1); PG8_STAGE(PG8_SA(1, 0), a3, voffA);
            PG8_BAR; PG8_WAIT_L(0); PG8_MMA(1, 0, At, B0); PG8_BAR; PG8_SCHED;
            PG8_STAGE(PG8_SB(1, 1), b3 + hstep, voffB);
            PG8_WAIT_V(6); PG8_BAR; PG8_MMA(1, 1, At, B1); PG8_BAR;
            }
        }
        if constexpr (ALIGN_EPI) { if (wr == 0) PG8_BAR; }
        if constexpr (!Epi::AFTER_DRAIN) { E(acc, cur, wr, wc, fr, fq); S.done(cur); }
        if (!has_next) break;
#pragma unroll
        for (int a = 0; a < 2; ++a)
#pragma unroll
            for (int b = 0; b < 2; ++b)
#pragma unroll
                for (int m = 0; m < 4; ++m)
#pragma unroll
                    for (int n = 0; n < 2; ++n) acc[a][b][m][n] = (f32x4){0.f, 0.f, 0.f, 0.f};
        cur = nxt; cA = nA; cB = nB; ++ui;
        if constexpr (ALIGN_EPI) { if (wr == 1) PG8_BAR; }
    }
    PG8_WAIT_V(0);
    if constexpr (!ALIGN_EPI) { if (wr == 0) PG8_BAR; }
    PG8_BAR;
    if constexpr (Epi::AFTER_DRAIN) { E.fused(acc, cur, wr, wc, fr, fq, lds, wid, lane); S.done(cur); }
#undef PG8_SA
#undef PG8_SB
#undef PG8_STAGE
#undef PG8_LDA
#undef PG8_LDB
#undef PG8_MMA
#undef PG8_WAIT_V
#undef PG8_WAIT_L
#undef PG8_BAR
#undef PG8_SCHED
}
}

#define LAS __attribute__((address_space(3)))
typedef unsigned short bf16_t;
typedef short bf16x8 __attribute__((ext_vector_type(8)));
typedef short s16x4 __attribute__((ext_vector_type(4)));
typedef float f32x4 __attribute__((ext_vector_type(4)));
typedef float f32x16 __attribute__((ext_vector_type(16)));
typedef unsigned u32x4 __attribute__((ext_vector_type(4)));
typedef unsigned u32x2 __attribute__((ext_vector_type(2)));

constexpr int NWAVES = 8, NTHR = 512;
constexpr int NB = 8, SEQ = 4096, DM = 1024, MTOK = NB * SEQ, PW = 2560, FF = 2816, NLAYER = 2;
constexpr int LDS_BYTES = 163840;
constexpr int LDS_XB_OFF = 159744;
constexpr float EPS = 1e-6f, LOG2E = 1.4426950408889634f, LN2 = 0.6931471805599453f;
constexpr size_t MiB = 1u << 20;
constexpr size_t WS_MOD = 0;
constexpr size_t WS_BAR = 512 * 1024;
constexpr size_t WS_W = 1 * MiB, W_LAYER = 24 * MiB;
constexpr size_t W_IN = 0, W_OUT = 5 * MiB, W_FI = 7 * MiB, W_FO = 18 * MiB;
constexpr size_t WS_H = 49 * MiB;
constexpr size_t WS_Z = 113 * MiB;
constexpr size_t BLK_E = (size_t)14 * MiB;
constexpr size_t ZSEG = (size_t)6 * 4096 * 64;
constexpr size_t UB_OFF_E = 6 * ZSEG;
constexpr size_t MIX_OFF_E = (size_t)10 * MiB;
constexpr size_t MIX_GAP_E = BLK_E - (size_t)4096 * 1024;
constexpr size_t ACT_GAP_E = BLK_E - (size_t)4096 * 2816;
constexpr size_t WS_OBR = 337 * MiB, OBR_STRIDE = 24 * MiB;
constexpr size_t WS_LSE = 433 * MiB;
constexpr size_t WS_X = 440 * MiB;
constexpr size_t WS_END = 504 * MiB;
static_assert(WS_Z + 8 * BLK_E * 2 <= WS_OBR && UB_OFF_E + (size_t)4096 * 256 <= MIX_OFF_E && MIX_OFF_E + (size_t)4096 * 1024 <= BLK_E && (size_t)4096 * 2816 <= BLK_E && W_FO + (size_t)DM * FF * 2 <= W_LAYER, "ws map");

__device__ __forceinline__ float wave_sum(float v) {
#pragma unroll
    for (int o = 1; o < 64; o <<= 1) v += __shfl_xor(v, o);
    return v;
}
__device__ __forceinline__ unsigned f2bf(float f) { unsigned u = __builtin_bit_cast(unsigned, f); return (u + 0x7fffu + ((u >> 16) & 1u)) >> 16; }
__device__ __forceinline__ unsigned pk2(float lo, float hi) { return f2bf(lo) | (f2bf(hi) << 16); }
__device__ __forceinline__ float bf_lo(unsigned w) { return __builtin_bit_cast(float, w << 16); }
__device__ __forceinline__ float bf_hi(unsigned w) { return __builtin_bit_cast(float, w & 0xffff0000u); }
#define LDS_WAIT() asm volatile("s_waitcnt lgkmcnt(0)" ::: "memory")

struct Args {
    const float *x, *c, *w_ada, *b_ada, *norm_mix, *w_in, *norm_a_out, *norm_c_out, *w_pool, *pool_scale, *rpb, *w_out, *norm_ffn, *w_ffn_in, *w_ffn_out, *norm_final;
    float* out; unsigned char* ws; int ph_lo, ph_hi;
};

template <bool SWG>
__device__ __forceinline__ void transpose_item(const float* W, int K, int N, bf16_t* WT, LAS float* scr, int item, int lane) {
    const int nblk = N / 32, kb = item / nblk, nb = item % nblk, k0 = 64 * kb, n0 = 32 * nb;
    int d0 = n0;
    if (SWG) { const int bj = n0 / FF, j = n0 % FF; d0 = 256 * (j / 128) + 128 * bj + (j % 128); }
    float tv[32];
#pragma unroll
    for (int i = 0; i < 32; ++i) tv[i] = W[(size_t)(k0 + 2 * i + (lane >> 5)) * N + n0 + (lane & 31)];
#pragma unroll
    for (int i = 0; i < 32; ++i) scr[(2 * i + (lane >> 5)) * 33 + (lane & 31)] = tv[i];
    LDS_WAIT();
    const int c = lane & 7;
#pragma unroll
    for (int j = 0; j < 4; ++j) { const int n = (lane >> 3) + 8 * j; const LAS float* s = scr + (8 * c) * 33 + n;
        u32x4 o; o.x = pk2(s[0 * 33], s[1 * 33]); o.y = pk2(s[2 * 33], s[3 * 33]); o.z = pk2(s[4 * 33], s[5 * 33]); o.w = pk2(s[6 * 33], s[7 * 33]);
        *(u32x4*)(WT + (size_t)(d0 + n) * K + k0 + 8 * c) = o; }
    LDS_WAIT();
}

__device__ __forceinline__ void phase_p0(const Args& a, LAS unsigned char* lds, int tid, int lane, int wave) {
    float* mod = (float*)(a.ws + WS_MOD);
    for (int item = blockIdx.x; item < 192; item += gridDim.x) {
        LAS float* sc = (LAS float*)lds;
        LAS float* red = (LAS float*)(lds + 32768);
        for (int i = tid; i < 8192; i += NTHR) { const float v = a.c[i]; sc[(i & 1023) * 8 + (i >> 10)] = v / (1.0f + __expf(-v)); }
        __syncthreads();
        const int l = item / 96, cb = item % 96, col = cb * 64 + lane;
        const float* wp = a.w_ada + (size_t)l * DM * 6144 + (size_t)(wave * 128) * 6144 + col;
        float acc0 = 0.f, acc1 = 0.f, acc2 = 0.f, acc3 = 0.f, acc4 = 0.f, acc5 = 0.f, acc6 = 0.f, acc7 = 0.f;
#pragma unroll 16
        for (int k = 0; k < 128; ++k) {
            const float w = wp[(size_t)k * 6144];
            const f32x4 s0 = *(const LAS f32x4*)(sc + (wave * 128 + k) * 8), s1 = *(const LAS f32x4*)(sc + (wave * 128 + k) * 8 + 4);
            acc0 += w * s0[0]; acc1 += w * s0[1]; acc2 += w * s0[2]; acc3 += w * s0[3]; acc4 += w * s1[0]; acc5 += w * s1[1]; acc6 += w * s1[2]; acc7 += w * s1[3];
        }
        red[(wave * 8 + 0) * 64 + lane] = acc0; red[(wave * 8 + 1) * 64 + lane] = acc1; red[(wave * 8 + 2) * 64 + lane] = acc2; red[(wave * 8 + 3) * 64 + lane] = acc3;
        red[(wave * 8 + 4) * 64 + lane] = acc4; red[(wave * 8 + 5) * 64 + lane] = acc5; red[(wave * 8 + 6) * 64 + lane] = acc6; red[(wave * 8 + 7) * 64 + lane] = acc7;
        __syncthreads();
        { const int b = wave; float s = 0.f;
#pragma unroll
          for (int w = 0; w < 8; ++w) s += red[(w * 8 + b) * 64 + lane];
          mod[((size_t)l * NB + b) * 6144 + col] = s + a.b_ada[(size_t)l * 6144 + col]; }
        __syncthreads();
    }
    LAS float* scr = (LAS float*)(lds + wave * 16384);
    const int gw = blockIdx.x * NWAVES + wave, NGW = gridDim.x * NWAVES;
    constexpr int I_IN = (DM / 64) * (PW / 32), I_OUT = (DM / 64) * (DM / 32), I_FI = (DM / 64) * (2 * FF / 32), I_FO = (FF / 64) * (DM / 32), I_L = I_IN + I_OUT + I_FI + I_FO;
    for (int it = gw; it < NLAYER * I_L; it += NGW) {
        const int l = it / I_L; int r = it % I_L;
        unsigned char* wl = a.ws + WS_W + (size_t)l * W_LAYER;
        if (r < I_IN) { transpose_item<false>(a.w_in + (size_t)l * DM * PW, DM, PW, (bf16_t*)(wl + W_IN), scr, r, lane); continue; } r -= I_IN;
        if (r < I_OUT) { transpose_item<false>(a.w_out + (size_t)l * DM * DM, DM, DM, (bf16_t*)(wl + W_OUT), scr, r, lane); continue; } r -= I_OUT;
        if (r < I_FI) { transpose_item<true>(a.w_ffn_in + (size_t)l * DM * 2 * FF, DM, 2 * FF, (bf16_t*)(wl + W_FI), scr, r, lane); continue; } r -= I_FI;
        transpose_item<false>(a.w_ffn_out + (size_t)l * FF * DM, FF, DM, (bf16_t*)(wl + W_FO), scr, r, lane);
    }
}

template <bool FINAL>
__device__ __forceinline__ void norm_rows(const float* X, const float* g, const float* sc, const float* sh, bf16_t* H, float* outF, int gw, int NGW, int lane) {
    for (int cj = 0; 16 * (gw + NGW * (cj >> 3)) < MTOK; ++cj) {
        const int m = 16 * (gw + NGW * (cj >> 3)) + 2 * (cj & 7);
        const f32x4* xr = (const f32x4*)(X + (size_t)m * DM) + lane;
        f32x4 v[2][4]; float s0 = 0.f, s1 = 0.f;
#pragma unroll
        for (int j = 0; j < 4; ++j) { v[0][j] = xr[64 * j]; v[1][j] = xr[256 + 64 * j]; }
#pragma unroll
        for (int j = 0; j < 4; ++j) { s0 += (v[0][j][0] * v[0][j][0] + v[0][j][1] * v[0][j][1]) + (v[0][j][2] * v[0][j][2] + v[0][j][3] * v[0][j][3]);
                                      s1 += (v[1][j][0] * v[1][j][0] + v[1][j][1] * v[1][j][1]) + (v[1][j][2] * v[1][j][2] + v[1][j][3] * v[1][j][3]); }
        const float rstd0 = 1.0f / sqrtf(wave_sum(s0) * (1.0f / DM) + EPS), rstd1 = 1.0f / sqrtf(wave_sum(s1) * (1.0f / DM) + EPS);
        const int b = m >> 12;
#pragma unroll
        for (int j = 0; j < 4; ++j) { const int col = 4 * lane + 256 * j; const f32x4 gv = *(const f32x4*)(g + col);
            f32x4 y0 = v[0][j] * rstd0 * gv, y1 = v[1][j] * rstd1 * gv;
            if (FINAL) { *(f32x4*)(outF + (size_t)m * DM + col) = y0; *(f32x4*)(outF + (size_t)(m + 1) * DM + col) = y1; }
            else { const f32x4 scv = *(const f32x4*)(sc + (size_t)b * 6144 + col) + 1.0f, shv = *(const f32x4*)(sh + (size_t)b * 6144 + col);
                y0 = y0 * scv + shv; y1 = y1 * scv + shv; u32x2 w0, w1; w0.x = pk2(y0[0], y0[1]); w0.y = pk2(y0[2], y0[3]); w1.x = pk2(y1[0], y1[1]); w1.y = pk2(y1[2], y1[3]);
                *(u32x2*)(H + (size_t)m * DM + col) = w0; *(u32x2*)(H + (size_t)(m + 1) * DM + col) = w1; } }
    }
}


template <bool FINAL>
__device__ __forceinline__ void norm_rows_bf(const bf16_t* X, const float* g, const float* sc, const float* sh, bf16_t* H, float* outF, int gw, int NGW, int lane) {
    constexpr int NR = 4;
    u32x4 raw[NR][2], nxt[NR][2];
    static_assert(NR == 4, "row chunking below assumes 4 rows per iteration");
#define NRB_ROW(cj_) (16 * (gw + NGW * ((cj_) >> 2)) + NR * ((cj_) & 3))
    { const int m = NRB_ROW(0); if (m < MTOK) { const u32x4* xr = (const u32x4*)(X + (size_t)m * DM) + lane;
#pragma unroll
        for (int r = 0; r < NR; ++r) { raw[r][0] = xr[128 * r]; raw[r][1] = xr[128 * r + 64]; } } }
    for (int cj = 0; NRB_ROW(cj) < MTOK; ++cj) {
        const int m = NRB_ROW(cj);
        { const int mn = NRB_ROW(cj + 1) < MTOK ? NRB_ROW(cj + 1) : m; const u32x4* xn = (const u32x4*)(X + (size_t)mn * DM) + lane;
#pragma unroll
          for (int r = 0; r < NR; ++r) { nxt[r][0] = xn[128 * r]; nxt[r][1] = xn[128 * r + 64]; } }
        float ss[NR];
#pragma unroll
        for (int r = 0; r < NR; ++r) { ss[r] = 0.f;
#pragma unroll
            for (int j = 0; j < 2; ++j)
#pragma unroll
                for (int e = 0; e < 4; ++e) { const unsigned w = raw[r][j][e]; const float lo = bf_lo(w), hi = bf_hi(w); ss[r] += lo * lo + hi * hi; } }
        float rstd[NR];
#pragma unroll
        for (int r = 0; r < NR; ++r) rstd[r] = 1.0f / sqrtf(wave_sum(ss[r]) * (1.0f / DM) + EPS);
        const int b = m >> 12;
#pragma unroll
        for (int j = 0; j < 2; ++j) { const int col = 8 * lane + 512 * j;
            float gg[8], aa[8], bb[8];
#pragma unroll
            for (int q = 0; q < 2; ++q) { const f32x4 gv = *(const f32x4*)(g + col + 4 * q);
                f32x4 scv = (f32x4){0.f, 0.f, 0.f, 0.f}, shv = scv;
                if (!FINAL) { scv = *(const f32x4*)(sc + (size_t)b * 6144 + col + 4 * q); shv = *(const f32x4*)(sh + (size_t)b * 6144 + col + 4 * q); }
#pragma unroll
                for (int e = 0; e < 4; ++e) { gg[4 * q + e] = gv[e]; aa[4 * q + e] = 1.0f + scv[e]; bb[4 * q + e] = shv[e]; } }
#pragma unroll
            for (int r = 0; r < NR; ++r) {
                float y[8];
#pragma unroll
                for (int e = 0; e < 4; ++e) { const unsigned w = raw[r][j][e]; y[2 * e] = bf_lo(w) * rstd[r] * gg[2 * e]; y[2 * e + 1] = bf_hi(w) * rstd[r] * gg[2 * e + 1]; }
                if (!FINAL) {
#pragma unroll
                    for (int e = 0; e < 8; ++e) y[e] = y[e] * aa[e] + bb[e]; }
                if (FINAL) { float* o = outF + (size_t)(m + r) * DM + col; *(f32x4*)o = (f32x4){y[0], y[1], y[2], y[3]}; *(f32x4*)(o + 4) = (f32x4){y[4], y[5], y[6], y[7]}; }
                else { u32x4 w; w.x = pk2(y[0], y[1]); w.y = pk2(y[2], y[3]); w.z = pk2(y[4], y[5]); w.w = pk2(y[6], y[7]); *(u32x4*)(H + (size_t)(m + r) * DM + col) = w; } } }
#pragma unroll
        for (int r = 0; r < NR; ++r) { raw[r][0] = nxt[r][0]; raw[r][1] = nxt[r][1]; }
    }
#undef NRB_ROW
}
#define LDS_BARRIER() asm volatile("s_waitcnt lgkmcnt(0)\n\ts_barrier" ::: "memory")
__device__ __forceinline__ void pool_phase(const Args& a, int l, LAS unsigned char* lds, int tid, int vb) {
    const bf16_t* UB = (const bf16_t*)(a.ws + WS_Z) + UB_OFF_E; bf16_t* MIX = (bf16_t*)(a.ws + WS_Z) + MIX_OFF_E;
    constexpr int PLP = 528, WTP = 144;
    LAS bf16_t* us = (LAS bf16_t*)lds;
    LAS unsigned char* plb = lds + 40960;
    LAS unsigned char* wt = lds + 40960 + 64 * PLP;
    static_assert(40960 + 64 * PLP + 256 * WTP <= 131072, "pool LDS map");
    const int G = gridDim.x; const bool xa = (G == 256);
    int unit = xa ? (vb & 7) * 64 + (vb >> 3) : vb; const int ustep = xa ? 32 : G, uend = xa ? (vb & 7) * 64 + 64 : 512;
    if (unit >= uend) return;
    const int c = tid & 255, g = c >> 6, th = tid >> 8, hw = 1 << g;
    const int wave = tid >> 6, lane = tid & 63, r = lane & 31, hh = lane >> 5, mg = wave & 3, mt = wave >> 2;
    { const float* wp = a.w_pool + (size_t)l * 4 * 4096;
      for (int i = tid; i < 4 * 4096; i += NTHR) { const int gg = i >> 12, cc = (i >> 6) & 63, dd = i & 63; *(LAS bf16_t*)(wt + (gg * 64 + dd) * WTP + cc * 2) = (bf16_t)f2bf(wp[i]); } }
    const float psc0 = a.pool_scale[l * 256 + mg * 64 + r], psc1 = a.pool_scale[l * 256 + mg * 64 + 32 + r];
    u32x4 pre[5];
#define POOL_LOAD(unit_) do { const int b_ = (unit_) >> 6, t0_ = ((unit_) & 63) * 64; _Pragma("unroll") for (int i_ = 0; i_ < 5; ++i_) { const int q_ = tid + NTHR * i_, rr_ = q_ >> 5, ch_ = q_ & 31, t_ = t0_ - 8 + rr_; \
        pre[i_] = (u32x4){0u, 0u, 0u, 0u}; if (t_ >= 0 && t_ < SEQ) pre[i_] = *(const u32x4*)(UB + (size_t)b_ * BLK_E + (size_t)t_ * 256 + ch_ * 8); } } while (0)
    POOL_LOAD(unit);
#define US(row_) __builtin_bit_cast(float, (unsigned)us[(row_) * 256 + c] << 16)
    for (; unit < uend; unit += ustep) {
        const int b = unit >> 6, t0 = (unit & 63) * 64;
        LDS_BARRIER();
#pragma unroll
        for (int i = 0; i < 5; ++i) { const int q = tid + NTHR * i, rr = q >> 5, ch = q & 31; *(LAS u32x4*)(us + rr * 256 + ch * 8) = pre[i]; }
        LDS_BARRIER();
        if (unit + ustep < uend) POOL_LOAD(unit + ustep);
        { const int tt0 = th * 32; float s = 0.f;
          for (int q = tt0 + 8 - hw; q <= tt0 + 8 + hw - 1; ++q) s += US(q);
          for (int tt = tt0; tt < tt0 + 32; tt += 4) {
              float av[4], bv[4], cv[4], ic[4];
#pragma unroll
              for (int e = 0; e < 4; ++e) { av[e] = US(tt + e + 8 + hw); bv[e] = US(tt + e + 8 - hw); cv[e] = US(tt + e + 8);
                  const int t = t0 + tt + e; int lo = t - hw; if (lo < 0) lo = 0; int hi = t + hw - 1; if (hi > SEQ - 1) hi = SEQ - 1; ic[e] = __builtin_amdgcn_rcpf((float)(hi - lo + 1)); }
#pragma unroll
              for (int e = 0; e < 4; ++e) { *(LAS bf16_t*)(plb + (tt + e) * PLP + c * 2) = (bf16_t)f2bf(s * ic[e] - cv[e]); s += av[e] - bv[e]; } } }
        LDS_BARRIER();
        {
          const LAS unsigned char* ap = plb + (32 * mt + r) * PLP + (mg * 64 + 8 * hh) * 2;
          const LAS unsigned char* bp = wt + (mg * 64 + r) * WTP + (8 * hh) * 2;
          f32x16 y0, y1;
#pragma unroll
          for (int i = 0; i < 16; ++i) { y0[i] = 0.f; y1[i] = 0.f; }
#pragma unroll
          for (int s4 = 0; s4 < 4; ++s4) { const bf16x8 af = *(const LAS bf16x8*)(ap + 32 * s4), b0 = *(const LAS bf16x8*)(bp + 32 * s4), b1 = *(const LAS bf16x8*)(bp + 32 * WTP + 32 * s4);
              y0 = __builtin_amdgcn_mfma_f32_32x32x16_bf16(af, b0, y0, 0, 0, 0); y1 = __builtin_amdgcn_mfma_f32_32x32x16_bf16(af, b1, y1, 0, 0, 0); }
          bf16_t* op = MIX + (size_t)b * BLK_E + (size_t)(t0 + 32 * mt + 4 * hh) * DM + 384 + mg * 64 + r;
#pragma unroll
          for (int i = 0; i < 16; ++i) { const int tk = (i & 3) + 8 * (i >> 2); op[(size_t)tk * DM] = (bf16_t)f2bf(y0[i] * psc0); op[(size_t)tk * DM + 32] = (bf16_t)f2bf(y1[i] * psc1); } }
    }
#undef US
#undef POOL_LOAD
    __syncthreads();
}

constexpr int VP = 144;
constexpr int KT_OFF = 0, VT_OFF = 384 * VP, RPB_OFF = 2 * 384 * VP, QT_OFF = 121856;
static_assert(RPB_OFF + 6 * 15 * 31 * 4 <= QT_OFF && QT_OFF + 256 * VP <= LDS_XB_OFF, "attention LDS map");
struct PassDesc { int mode, b, h, ls, res, i0, r0, sub; };
#define D_KRLO(d_) rstart_of((d_).r0)
#define D_KRHI(d_) (rstart_of((d_).r0 + 3) + 7)
__device__ __forceinline__ int rstart_of(int r) { int s = r - 4; return s < 0 ? 0 : (s > 56 ? 56 : s); }
__device__ __forceinline__ s16x4 vtr(const LAS unsigned char* p) { return __builtin_bit_cast(s16x4, __builtin_amdgcn_ds_read_tr16_b64_v4i16((LAS s16x4*)p)); }
constexpr int NA_UNITS = 48 * 3 * 16, NC_UNITS = 48 * 16;

__device__ __forceinline__ void get_pass(int s, int nA, PassDesc& d, int vb) {
    const int x = vb & 7, li = vb >> 3, G = gridDim.x; const bool xa = (G == 256);
    d.mode = 0; d.b = 0; d.h = 0; d.ls = 0; d.res = 0; d.i0 = 0; d.r0 = 0; d.sub = 0;
    if (s < nA) { const int ia = xa ? li + 32 * s : vb + s * G, bh = (xa ? 6 * x : 0) + ia / 48, u = ia % 48, br = u >> 4, q = u & 15; d.mode = 0; d.b = bh / 6; d.h = bh % 6; d.ls = 2 * br;
        const int cpr = 16 >> d.ls;
        d.res = q / cpr; d.i0 = (q % cpr) * 256; }
    else { const int c = s - nA, ic = xa ? li + 32 * (c >> 1) : vb + (c >> 1) * G, bh = (xa ? 6 * x : 0) + ic / 16, quad = ic & 15; d.mode = 1; d.b = bh / 6; d.h = bh % 6; d.sub = c & 1; d.r0 = 4 * quad; }
}
__device__ __forceinline__ int pass_qtok(const PassDesc& d, int wave, int lane) {
    const int r = lane & 31;
    return d.mode == 0 ? (((d.i0 + 32 * wave + r) << d.ls) + d.res) : ((d.r0 + 2 * (wave >> 2) + (r >> 4)) * 64 + 16 * (wave & 3) + (r & 15));
}
__device__ __forceinline__ void attn_load_kv(const PassDesc& d, const bf16_t* Z, int tid, u32x4 (&kr)[6], u32x4 (&vr)[6]) {
    const bf16_t* Kb = Z + (size_t)d.b * BLK_E + (size_t)(d.mode == 0 ? 1 : 4) * ZSEG + (size_t)d.h * SEQ * 64;
    const int n = SEQ >> d.ls;
    int tq_ = tid; asm volatile("" : "+v"(tq_));
#pragma unroll
    for (int i = 0; i < 6; ++i) { const int q = tq_ + NTHR * i, row = q >> 3, ch = q & 7; int tok;
        if (d.mode == 0) { int j = d.i0 - 64 + row; j = j < 0 ? 0 : (j > n - 1 ? n - 1 : j); tok = (j << d.ls) + d.res; }
        else { const int krhi_ = D_KRHI(d); int kr_ = D_KRLO(d) + 6 * d.sub + (row >> 6); kr_ = kr_ > krhi_ ? krhi_ : kr_; tok = kr_ * 64 + (row & 63); }
        const bf16_t* p = Kb + tok * 64 + ch * 8; kr[i] = *(const u32x4*)p; vr[i] = *(const u32x4*)(p + ZSEG); }
}
__device__ __forceinline__ void attn_load_q(const PassDesc& d, const bf16_t* Z, int wave, int lane, bf16x8 (&qf)[4]) {
    const bf16_t* qp = Z + (size_t)d.b * BLK_E + (size_t)(d.mode == 0 ? 0 : 3) * ZSEG + ((size_t)d.h * SEQ + pass_qtok(d, wave, lane)) * 64 + 8 * (lane >> 5);
#pragma unroll
    for (int s = 0; s < 4; ++s) qf[s] = *(const bf16x8*)(qp + 16 * s);
}
__device__ __forceinline__ void attn_stage(LAS unsigned char* lds, int tid, const u32x4 (&kr)[6], const u32x4 (&vr)[6], const bf16x8 (&qf)[4]) {
    { const int wave_ = tid >> 6, lane_ = tid & 63; LAS unsigned char* qp_ = lds + QT_OFF + (32 * wave_ + (lane_ & 31)) * VP + 16 * (lane_ >> 5);
#pragma unroll
      for (int s_ = 0; s_ < 4; ++s_) *(LAS bf16x8*)(qp_ + 32 * s_) = qf[s_]; }
    int ts_ = tid; asm volatile("" : "+v"(ts_));
#pragma unroll
    for (int i = 0; i < 6; ++i) { const int q = ts_ + NTHR * i, row = q >> 3, ch = q & 7;
        *(LAS u32x4*)(lds + KT_OFF + row * VP + ch * 16) = kr[i]; *(LAS u32x4*)(lds + VT_OFF + row * VP + ch * 16) = vr[i]; }
}

struct AttnLane { int r, hh, n, qi, rq, cq, cstart, rs, kc0; float slope2, mid, hwid; };

template <int MODE, int NT>
__device__ __forceinline__ void attn_step(const PassDesc& d, const AttnLane& L, LAS unsigned char* lds, const LAS float* rpbl, float& m, float& l, f32x16& o0, f32x16& o1, int wave, int lane, int st) {
    typedef float f32x2 __attribute__((ext_vector_type(2)));
    const int r = L.r, hh = L.hh;
    int rowbase[NT], jb[NT], krow[NT];
#pragma unroll
    for (int t = 0; t < NT; ++t) { rowbase[t] = (MODE == 0) ? 32 * (wave + st + t) : 64 * (st + t) + L.kc0; jb[t] = d.i0 - 64 + rowbase[t]; krow[t] = D_KRLO(d) + 6 * d.sub + st + t; }
    f32x16 sa[NT];
#pragma unroll
    for (int t = 0; t < NT; ++t) { const LAS unsigned char* kp = lds + KT_OFF + (rowbase[t] + r) * VP + 16 * hh; const LAS unsigned char* qp = lds + QT_OFF + (32 * wave + r) * VP + 16 * hh; bf16x8 kf[4], qf[4];
#pragma unroll
        for (int s = 0; s < 4; ++s) { kf[s] = *(const LAS bf16x8*)(kp + 32 * s); qf[s] = *(const LAS bf16x8*)(qp + 32 * s); }
#pragma unroll
        for (int i = 0; i < 16; ++i) sa[t][i] = 0.f;
#pragma unroll
        for (int s = 0; s < 4; ++s) sa[t] = __builtin_amdgcn_mfma_f32_32x32x16_bf16(kf[s], qf[s], sa[t], 0, 0, 0);
        __builtin_amdgcn_sched_barrier(0); }
    float mloc = -1e30f;
#pragma unroll
    for (int t = 0; t < NT; ++t) {
        if (MODE == 0) {
            const float rel0 = (float)(jb[t] + 4 * hh - L.qi);
            const f32x2 r2 = (f32x2){rel0, rel0}, m2 = (f32x2){rel0 - L.mid, rel0 - L.mid}, ns2 = (f32x2){-L.slope2, -L.slope2};
#pragma unroll
            for (int i = 0; i < 16; i += 2) { const f32x2 c2 = (f32x2){(float)((i & 3) + 8 * (i >> 2)), (float)(((i + 1) & 3) + 8 * ((i + 1) >> 2))};
                const f32x2 rel = r2 + c2, rc = m2 + c2; const f32x2 ar = (f32x2){__builtin_fabsf(rel.x), __builtin_fabsf(rel.y)};
                const f32x2 s2 = ar * ns2 + (f32x2){sa[t][i], sa[t][i + 1]};
                sa[t][i] = (__builtin_fabsf(rc.x) <= L.hwid) ? s2.x : -1e30f; sa[t][i + 1] = (__builtin_fabsf(rc.y) <= L.hwid) ? s2.y : -1e30f; }
        } else {
            const LAS float* bp = rpbl + (d.h * 15 + (krow[t] - L.rq + 7)) * 31 + (L.kc0 + 4 * hh - L.cq + 15);
            float bias[16];
#pragma unroll
            for (int i = 0; i < 16; ++i) bias[i] = bp[(i & 3) + 8 * (i >> 2)];
            const bool rok = (krow[t] >= L.rs) && (krow[t] <= L.rs + 7); const float cm = rok ? (float)(L.cstart - L.kc0 - 4 * hh) + 7.5f : 1e9f;
#pragma unroll
            for (int i = 0; i < 16; ++i) { const float ci = (float)((i & 3) + 8 * (i >> 2)); const float s = sa[t][i] + bias[i]; sa[t][i] = (__builtin_fabsf(ci - cm) <= 7.5f) ? s : -1e30f; }
        }
#pragma unroll
        for (int i = 0; i < 16; ++i) mloc = fmaxf(mloc, sa[t][i]);
    }
    mloc = fmaxf(mloc, __shfl_xor(mloc, 32));
    const float mn = fmaxf(m, mloc), alpha = __builtin_amdgcn_exp2f(m - mn); m = mn;
    float ps = 0.f;
#pragma unroll
    for (int t = 0; t < NT; ++t)
#pragma unroll
        for (int i = 0; i < 16; ++i) { sa[t][i] = __builtin_amdgcn_exp2f(sa[t][i] - mn); ps += sa[t][i]; }
    l = l * alpha + ps;
#pragma unroll
    for (int i = 0; i < 16; ++i) { o0[i] *= alpha; o1[i] *= alpha; }
#pragma unroll
    for (int t = 0; t < NT; ++t) {
        bf16x8 pb[2];
#pragma unroll
        for (int s2 = 0; s2 < 2; ++s2) { u32x4 w; w.x = pg8::cvt_pk_bf16(sa[t][8 * s2 + 0], sa[t][8 * s2 + 1]); w.y = pg8::cvt_pk_bf16(sa[t][8 * s2 + 2], sa[t][8 * s2 + 3]);
            w.z = pg8::cvt_pk_bf16(sa[t][8 * s2 + 4], sa[t][8 * s2 + 5]); w.w = pg8::cvt_pk_bf16(sa[t][8 * s2 + 6], sa[t][8 * s2 + 7]); pb[s2] = __builtin_bit_cast(bf16x8, w); }
        __builtin_amdgcn_sched_barrier(0);
        const LAS unsigned char* vb = lds + VT_OFF + (rowbase[t] + 4 * hh + ((lane & 15) >> 2)) * VP + (16 * (r >> 4) + 4 * (lane & 3)) * 2;
#pragma unroll
        for (int s2 = 0; s2 < 2; ++s2) {
            const s16x4 a00 = vtr(vb + (16 * s2) * VP), a01 = vtr(vb + (16 * s2 + 8) * VP), a10 = vtr(vb + (16 * s2) * VP + 64), a11 = vtr(vb + (16 * s2 + 8) * VP + 64);
            const bf16x8 A0 = (bf16x8){a00[0], a00[1], a00[2], a00[3], a01[0], a01[1], a01[2], a01[3]}, A1 = (bf16x8){a10[0], a10[1], a10[2], a10[3], a11[0], a11[1], a11[2], a11[3]};
            o0 = __builtin_amdgcn_mfma_f32_32x32x16_bf16(A0, pb[s2], o0, 0, 0, 0);
            o1 = __builtin_amdgcn_mfma_f32_32x32x16_bf16(A1, pb[s2], o1, 0, 0, 0); } }
}

template <int MODE>
__device__ __forceinline__ void attn_compute(const PassDesc& d, LAS unsigned char* lds, const LAS float* rpbl, float& m, float& l, f32x16& o0, f32x16& o1, int wave, int lane) {
    AttnLane L; L.r = lane & 31; L.hh = lane >> 5;
    L.n = SEQ >> d.ls; L.qi = d.i0 + 32 * wave + L.r;
    L.slope2 = exp2f(-8.0f * (float)(d.h + 1) / 6.0f) * LOG2E * (float)(1 << d.ls);
    { const float lo = fmaxf(-64.0f, (float)(-L.qi)), hi = fminf(64.0f, (float)(L.n - 1 - L.qi)); L.mid = 0.5f * (lo + hi); L.hwid = 0.5f * (hi - lo); }
    const int pair = wave >> 2, g = wave & 3; L.rq = d.r0 + 2 * pair + (L.r >> 4); L.cq = 16 * g + (L.r & 15);
    { int cs = L.cq - 8; L.cstart = cs < 0 ? 0 : (cs > 48 ? 48 : cs); }
    L.rs = rstart_of(L.rq); L.kc0 = (g == 0) ? 0 : (g == 1 ? 8 : (g == 2 ? 24 : 32));
    const int wlo = rstart_of(d.r0 + 2 * pair), whi = rstart_of(d.r0 + 2 * pair + 1) + 7;
    constexpr int NST = (MODE == 0) ? 5 : 6;
    int s_lo = NST, s_hi = 0;
#pragma unroll
    for (int st = 0; st < NST; ++st) { bool act;
        if (MODE == 0) { const int jb_ = d.i0 - 64 + 32 * (wave + st); act = !(jb_ + 31 < 0 || jb_ >= L.n); }
        else { const int kr_ = D_KRLO(d) + 6 * d.sub + st; act = !(kr_ > D_KRHI(d) || kr_ < wlo || kr_ > whi); }
        if (act) { s_lo = st < s_lo ? st : s_lo; s_hi = st + 1; } }
#pragma unroll 1
    for (int st = s_lo; st < s_hi; st += 2) {
        if (st + 1 < s_hi) attn_step<MODE, 2>(d, L, lds, rpbl, m, l, o0, o1, wave, lane, st);
        else attn_step<MODE, 1>(d, L, lds, rpbl, m, l, o0, o1, wave, lane, st);
    }
}
__device__ __forceinline__ void attn_final(const Args& a, const PassDesc& d, float m, float l, const f32x16& o0, const f32x16& o1, int wave, int lane) {
    const int hh = lane >> 5, tq = pass_qtok(d, wave, lane);
    const float lt = l + __shfl_xor(l, 32), inv = 1.0f / lt;
    const int slot = d.mode == 0 ? (d.ls >> 1) : 3;
    bf16_t* op = (bf16_t*)(a.ws + WS_OBR + (size_t)slot * OBR_STRIDE) + ((size_t)d.b * SEQ + tq) * 384 + d.h * 64 + 4 * hh;
#pragma unroll
    for (int g4 = 0; g4 < 4; ++g4) {
        u32x2 w0, w1; w0.x = pk2(o0[4 * g4] * inv, o0[4 * g4 + 1] * inv); w0.y = pk2(o0[4 * g4 + 2] * inv, o0[4 * g4 + 3] * inv);
        w1.x = pk2(o1[4 * g4] * inv, o1[4 * g4 + 1] * inv); w1.y = pk2(o1[4 * g4 + 2] * inv, o1[4 * g4 + 3] * inv);
        *(u32x2*)(op + 8 * g4) = w0; *(u32x2*)(op + 32 + 8 * g4) = w1; }
    if (d.mode == 0 && hh == 0) ((float*)(a.ws + WS_LSE))[((size_t)(d.ls >> 1) * MTOK + (size_t)d.b * SEQ + tq) * 6 + d.h] = (m + __log2f(lt)) * LN2;
}

__device__ __forceinline__ void phase_mix(const Args& a, int l, LAS unsigned char* lds, int tid, int lane, int wave, int vb) {
    pool_phase(a, l, lds, tid, vb);
    LAS float* rpbl = (LAS float*)(lds + RPB_OFF);
    for (int i = tid; i < 6 * 15 * 31; i += NTHR) rpbl[i] = a.rpb[(size_t)l * 2790 + i] * LOG2E;
    const bf16_t* Z = (const bf16_t*)(a.ws + WS_Z);
    const int G = gridDim.x, bx = vb;
    const int nA = (G == 256) ? 9 : (bx < NA_UNITS ? (NA_UNITS - bx + G - 1) / G : 0), nC = (G == 256) ? 3 : (bx < NC_UNITS ? (NC_UNITS - bx + G - 1) / G : 0), npass = nA + 2 * nC;
    PassDesc cur, nxt; u32x4 kr[6], vr[6]; bf16x8 qc[4];
    float m = -1e30f, lsum = 0.f; f32x16 o0, o1;
#pragma unroll
    for (int i = 0; i < 16; ++i) { o0[i] = 0.f; o1[i] = 0.f; }
    get_pass(0, nA, cur, vb); nxt = cur;
    if (npass > 0) { attn_load_kv(cur, Z, tid, kr, vr); attn_load_q(cur, Z, wave, lane, qc); }
#pragma unroll 1
    for (int s = 0; s < npass; ++s) {
        LDS_BARRIER();
        attn_stage(lds, tid, kr, vr, qc);
        LDS_BARRIER();
        if (s + 1 < npass) { get_pass(s + 1, nA, nxt, vb); attn_load_kv(nxt, Z, tid, kr, vr); attn_load_q(nxt, Z, wave, lane, qc); }
        if (cur.mode == 0 || cur.sub == 0) { m = -1e30f; lsum = 0.f;
#pragma unroll
            for (int i = 0; i < 16; ++i) { o0[i] = 0.f; o1[i] = 0.f; } }
        if (cur.mode == 0) attn_compute<0>(cur, lds, rpbl, m, lsum, o0, o1, wave, lane);
        else attn_compute<1>(cur, lds, rpbl, m, lsum, o0, o1, wave, lane);
        if (cur.mode == 0 || cur.sub == 1) attn_final(a, cur, m, lsum, o0, o1, wave, lane);
        cur = nxt;
    }
    __syncthreads();
}

__device__ __forceinline__ void phase_combine(const Args& a, int l, int lane, int gw, int NGW) {
    const bf16_t* __restrict__ OB = (const bf16_t*)(a.ws + WS_OBR); const float* __restrict__ LSE = (const float*)(a.ws + WS_LSE); bf16_t* __restrict__ MIX = (bf16_t*)(a.ws + WS_Z) + MIX_OFF_E;
    constexpr size_t OS = OBR_STRIDE / 2; constexpr int NT = 4;
    const bool act = lane < 48; const int ch = act ? 8 * lane : 0, hd = ch >> 6;
    float ga[8], gc[8];
    { const f32x4 a0 = *(const f32x4*)(a.norm_a_out + l * 384 + ch), a1 = *(const f32x4*)(a.norm_a_out + l * 384 + ch + 4), c0 = *(const f32x4*)(a.norm_c_out + l * 384 + ch), c1 = *(const f32x4*)(a.norm_c_out + l * 384 + ch + 4);
#pragma unroll
      for (int e = 0; e < 4; ++e) { ga[e] = a0[e]; ga[4 + e] = a1[e]; gc[e] = c0[e]; gc[4 + e] = c1[e]; } }
    for (int cj = 0; 16 * (gw + NGW * (cj >> 2)) < MTOK; ++cj) {
        const int tok0 = 16 * (gw + NGW * (cj >> 2)) + NT * (cj & 3);
        u32x4 w[NT][4]; float ls[NT][3];
#pragma unroll
        for (int t = 0; t < NT; ++t) { const size_t tok = tok0 + t;
#pragma unroll
            for (int br = 0; br < 4; ++br) w[t][br] = *(const u32x4*)(OB + br * OS + tok * 384 + ch);
#pragma unroll
            for (int br = 0; br < 3; ++br) ls[t][br] = LSE[((size_t)br * MTOK + tok) * 6 + hd]; }
#pragma unroll
        for (int t = 0; t < NT; ++t) { const size_t tok = tok0 + t;
            const float l0 = ls[t][0], l1 = ls[t][1], l2 = ls[t][2];
            const float mx = fmaxf(l0, fmaxf(l1, l2)), e0 = __expf(l0 - mx), e1 = __expf(l1 - mx), e2 = __expf(l2 - mx), inv = 1.0f / (e0 + e1 + e2);
            float va[8], vc[8]; float ssa = 0.f, ssc = 0.f;
#pragma unroll
            for (int e = 0; e < 4; ++e) { const unsigned w0 = w[t][0][e], w1 = w[t][1][e], w2 = w[t][2][e], w3 = w[t][3][e];
                va[2 * e] = (e0 * bf_lo(w0) + e1 * bf_lo(w1) + e2 * bf_lo(w2)) * inv; va[2 * e + 1] = (e0 * bf_hi(w0) + e1 * bf_hi(w1) + e2 * bf_hi(w2)) * inv;
                vc[2 * e] = bf_lo(w3); vc[2 * e + 1] = bf_hi(w3);
                ssa += va[2 * e] * va[2 * e] + va[2 * e + 1] * va[2 * e + 1]; ssc += vc[2 * e] * vc[2 * e] + vc[2 * e + 1] * vc[2 * e + 1]; }
            if (!act) { ssa = 0.f; ssc = 0.f; }
            const float ra = 1.0f / sqrtf(wave_sum(ssa) * (1.0f / 384.0f) + EPS), rc = 1.0f / sqrtf(wave_sum(ssc) * (1.0f / 384.0f) + EPS);
            if (act) { u32x4 oa, oc;
#pragma unroll
                for (int e = 0; e < 4; ++e) { oa[e] = pk2(va[2 * e] * ra * ga[2 * e], va[2 * e + 1] * ra * ga[2 * e + 1]); oc[e] = pk2(vc[2 * e] * rc * gc[2 * e], vc[2 * e + 1] * rc * gc[2 * e + 1]); }
                bf16_t* mp = MIX + (tok >> 12) * BLK_E + (tok & 4095) * DM + ch; *(u32x4*)mp = oa; *(u32x4*)(mp + 640) = oc; } }
    }
}

#define XB_TMO      128
#define XB_XCNT(j)  (256  + 64 * (j))
#define XB_XSUB(j)  (1280 + 64 * (j))
#define XB_XGEN(j)  (2304 + 64 * (j))
#define XB_TOP      3328
#define XB_TOPGEN   3392
#define XCD_BAR_WORDS 3456
#define XB_SPIN_CAP (1u << 18)

__device__ __forceinline__ unsigned xb_ld(unsigned* p)              { return __hip_atomic_load(p, __ATOMIC_RELAXED, __HIP_MEMORY_SCOPE_AGENT); }
__device__ __forceinline__ unsigned xb_add(unsigned* p, unsigned v) { return __hip_atomic_fetch_add(p, v, __ATOMIC_RELAXED, __HIP_MEMORY_SCOPE_AGENT); }
__device__ __forceinline__ unsigned xb_xcc_id() { return (unsigned)__builtin_amdgcn_s_getreg((3 << 11) | 20) & 0xFu; }
#define XB_SPIN(cond, bar) do { unsigned _sp = 0; while (cond) { __builtin_amdgcn_s_sleep(1); \
    if ((++_sp & 255u) == 0u) { if (xb_ld(&(bar)[XB_TMO])) break; if (_sp > XB_SPIN_CAP) { atomicAdd(&(bar)[XB_TMO], 1u); break; } } } } while (0)

struct XcdBarrier {
    unsigned* bar; unsigned x;
    volatile LAS unsigned* st;
};

__device__ __forceinline__ XcdBarrier xcd_barrier_post(unsigned* bar, volatile LAS unsigned* st) {
    XcdBarrier b; b.bar = bar; b.x = xb_xcc_id(); b.st = st;
    if (threadIdx.x == 0) st[2] = xb_add(&bar[XB_XCNT(b.x)], 1u);
    return b;
}
__device__ __forceinline__ void xcd_barrier_complete(unsigned* bar, unsigned x, unsigned& nloc, unsigned& nx, unsigned& reg) {
    const unsigned G = gridDim.x * gridDim.y * gridDim.z;
    unsigned sum, cnt, mine, sp = 0u;
    for (;;) {
        sum = 0u; cnt = 0u; mine = 0u;
#pragma unroll
        for (unsigned j = 0; j < 16; ++j) { const unsigned c = xb_ld(&bar[XB_XCNT(j)]); sum += c; cnt += (c > 0u) ? 1u : 0u; mine = (j == x) ? c : mine; }
        if (sum == G) break;
        __builtin_amdgcn_s_sleep(1);
        if ((++sp & 255u) == 0u) { if (xb_ld(&bar[XB_TMO])) break; if (sp > XB_SPIN_CAP) { atomicAdd(&bar[XB_TMO], 1u); break; } }
    }
    nloc = mine > 0u ? mine : 1u; nx = cnt > 0u ? cnt : 1u;
    { unsigned ok = (sum == G && G == 256u && x < 8u) ? 1u : 0u;
#pragma unroll
      for (unsigned j = 0; j < 16; ++j) { const unsigned c = xb_ld(&bar[XB_XCNT(j)]); if (c != (j < 8u ? 32u : 0u)) ok = 0u; }
      reg = ok; }
}

__device__ __forceinline__ void xcd_barrier(const XcdBarrier& b) {
    asm volatile("s_waitcnt vmcnt(0)" ::: "memory");
    __syncthreads();
    if (threadIdx.x == 0) {
        unsigned* bar = b.bar;
        __builtin_amdgcn_s_waitcnt(0);
        unsigned nloc = b.st[0], nx = b.st[1];
        if (nloc == 0u) { unsigned reg = 0u; xcd_barrier_complete(bar, b.x, nloc, nx, reg); b.st[0] = nloc; b.st[1] = nx; b.st[3] = reg; }
        const unsigned old = xb_add(&bar[XB_XSUB(b.x)], 1u);
        const unsigned gen = old / nloc;
        if (old + 1u == (gen + 1u) * nloc) {
            __builtin_amdgcn_fence(__ATOMIC_RELEASE, "agent");
            asm volatile("s_waitcnt vmcnt(0)" ::: "memory");
            const unsigned og = xb_add(&bar[XB_TOP], 1u);
            const unsigned tg = og / nx;
            if (og + 1u == (tg + 1u) * nx) xb_add(&bar[XB_TOPGEN], 1u);
            else XB_SPIN(xb_ld(&bar[XB_TOPGEN]) == tg, bar);
            __builtin_amdgcn_fence(__ATOMIC_ACQUIRE, "agent");
            xb_add(&bar[XB_XGEN(b.x)], 1u);
            asm volatile("s_waitcnt vmcnt(0)" ::: "memory");
        } else {
            XB_SPIN(xb_ld(&bar[XB_XGEN(b.x)]) == gen, bar);
            __builtin_amdgcn_fence(__ATOMIC_ACQUIRE, "agent");
            asm volatile("s_waitcnt vmcnt(0)" ::: "memory");
        }
    }
    __syncthreads();
}

__device__ __forceinline__ void xcd_barrier_local(const XcdBarrier& b) {
    asm volatile("s_waitcnt vmcnt(0)" ::: "memory");
    __syncthreads();
    if (threadIdx.x == 0) {
        unsigned* bar = b.bar;
        __builtin_amdgcn_s_waitcnt(0);
        const unsigned nloc = b.st[0];
        const unsigned old = xb_add(&bar[XB_XSUB(b.x)], 1u);
        const unsigned gen = old / nloc;
        if (old + 1u == (gen + 1u) * nloc) xb_add(&bar[XB_XGEN(b.x)], 1u);
        else XB_SPIN(xb_ld(&bar[XB_XGEN(b.x)]) == gen, bar);
        __builtin_amdgcn_fence(__ATOMIC_ACQUIRE, "agent");
        asm volatile("s_waitcnt vmcnt(0)" ::: "memory");
    }
    __syncthreads();
}
#ifndef PH_MASK
#define PH_MASK 0x3ff
#endif
#ifndef REP_MASK
#define REP_MASK 0
#endif
constexpr unsigned REPM = REP_MASK;
constexpr unsigned PHM = PH_MASK;
constexpr int N_PHASES = 18;
__global__ void __launch_bounds__(NTHR, 2) fwd_mega(Args a) {
    extern __shared__ __attribute__((aligned(16))) unsigned char lds_raw[];
    LAS unsigned char* lds = (LAS unsigned char*)lds_raw;
    const int n_it = (a.ph_hi - a.ph_lo) * (REPM ? 2 : 1);
    volatile LAS unsigned* xst = (volatile LAS unsigned*)(lds + LDS_XB_OFF);
    if (threadIdx.x < 4) xst[threadIdx.x] = 0u;
    __syncthreads();
    if (a.ph_lo < 0) cg::this_grid().sync();
    const XcdBarrier xbar = xcd_barrier_post((unsigned*)(a.ws + WS_BAR), xst);
    for (int it = 0; it < n_it; ++it) {
        const int ph = a.ph_lo + (REPM ? (it >> 1) : it);
        if (REPM && (it & 1) && !((ph >= 1 && ph < N_PHASES - 1 && ((REPM >> ((ph - 1) & 7)) & 1u)) || (ph == 0 && (REPM & 0x100u)))) continue;
        const bool dummy = REPM && (it & 1);
        if (it == 1) xcd_barrier(xbar);
        const bool regular = it >= 1 && __builtin_amdgcn_readfirstlane((int)xst[3]) != 0;
        if (it > 1) { if (regular) xcd_barrier_local(xbar); else xcd_barrier(xbar); }
        const int vb = regular ? __builtin_amdgcn_readfirstlane((int)(xst[2] * 8u + xbar.x)) : (int)blockIdx.x;
        int tid = threadIdx.x; asm volatile("" : "+v"(tid));
        const int lane = tid & 63, wave = __builtin_amdgcn_readfirstlane(tid >> 6);
        const int NGW = gridDim.x * NWAVES, gw = (gridDim.x == 256) ? 256 * (vb & 7) + 8 * (vb >> 3) + wave : vb * NWAVES + wave;
        if (ph == 0) { if (PHM & 1) phase_p0(a, lds, tid, lane, wave); continue; }
        if (ph == N_PHASES - 1) { if (PHM & 2) norm_rows_bf<true>((const bf16_t*)(a.ws + WS_X), a.norm_final, nullptr, nullptr, nullptr, a.out, gw, NGW, lane); continue; }
        const int l = (ph - 1) >> 3, k = (ph - 1) & 7;
        const float* modl = (const float*)(a.ws + WS_MOD) + (size_t)l * NB * 6144;
        bf16_t* H = (bf16_t*)(a.ws + WS_H); bf16_t* Z = (bf16_t*)(a.ws + WS_Z); bf16_t* MIX = (bf16_t*)(a.ws + WS_Z) + MIX_OFF_E; bf16_t* ACT = (bf16_t*)(a.ws + WS_Z);
        const unsigned char* wl = a.ws + WS_W + (size_t)l * W_LAYER;
        bf16_t* XS = (bf16_t*)(a.ws + WS_X);
        if (k == 0) { if (PHM & 4) { if (l == 0) norm_rows<false>(a.x, a.norm_mix + l * DM, modl + 1024, modl, H, nullptr, gw, NGW, lane);
                                         else norm_rows_bf<false>(XS, a.norm_mix + l * DM, modl + 1024, modl, H, nullptr, gw, NGW, lane); } }
        else if (k == 1) { if (PHM & 8) { pg8::Gemm g{H, (const bf16_t*)(wl + W_IN), MTOK, PW, DM, 0}; pg8::StaticOrder S; S.init(MTOK, PW, gridDim.x, vb);
            pg8::EpiZH E{Z}; pg8::gemm_phase<pg8::EpiZH, pg8::StaticOrder, true, true>(lds, g, S, E, tid); } }
        else if (k == 2) { if (PHM & 16) phase_mix(a, l, lds, tid, lane, wave, vb); }
        else if (k == 3) { if (PHM & 32) phase_combine(a, l, lane, gw, NGW); }
        else if (k == 4) { if (PHM & 64) { pg8::Gemm g{MIX, (const bf16_t*)(wl + W_OUT), MTOK, DM, DM, MIX_GAP_E}; pg8::StaticOrder S; S.init(MTOK, DM, gridDim.x, vb);
            if (l == 0) { pg8::EpiResid<true> E{a.x, dummy ? (bf16_t*)(a.ws + 337 * MiB) : XS, modl + 2048}; pg8::gemm_phase<pg8::EpiResid<true>, pg8::StaticOrder, true, true>(lds, g, S, E, tid); }
            else { pg8::EpiResid<false> E{XS, XS, modl + 2048}; pg8::gemm_phase<pg8::EpiResid<false>, pg8::StaticOrder, true, true>(lds, g, S, E, tid); } } }
        else if (k == 5) { if (PHM & 128) norm_rows_bf<false>(XS, a.norm_ffn + l * DM, modl + 4096, modl + 3072, H, nullptr, gw, NGW, lane); }
        else if (k == 6) { if (PHM & 256) { pg8::Gemm g{H, (const bf16_t*)(wl + W_FI), MTOK, 2 * FF, DM, 0}; pg8::StaticOrder S; S.init(MTOK, 2 * FF, gridDim.x, vb);
            pg8::EpiSwiGLU E{ACT, FF, ACT_GAP_E}; pg8::gemm_phase<pg8::EpiSwiGLU, pg8::StaticOrder, true, true>(lds, g, S, E, tid); } }
        else { if (PHM & 512) { pg8::Gemm g{ACT, (const bf16_t*)(wl + W_FO), MTOK, DM, FF, ACT_GAP_E}; pg8::StaticOrder S; S.init(MTOK, DM, gridDim.x, vb);
            pg8::EpiResid<false> E{XS, dummy ? (bf16_t*)(a.ws + 337 * MiB) : XS, modl + 5120}; pg8::gemm_phase<pg8::EpiResid<false>, pg8::StaticOrder, true, true>(lds, g, S, E, tid); } }
    }
}

extern "C" void kernel_launch(void* const* d_in, const int* in_sizes, int n_in, void* d_out, int out_size, void* d_ws, size_t ws_size, hipStream_t stream) {
    static int grid = 0;
    if (grid == 0) {
        if (n_in != 16 || out_size != MTOK * DM || ws_size < WS_END) { fprintf(stderr, "kernel_launch: unexpected shapes (n_in %d out %d ws %zu)\n", n_in, out_size, ws_size); grid = -1; return; }
        int dev = 0, cus = 0, per_cu = 0;
        hipGetDevice(&dev); hipDeviceGetAttribute(&cus, hipDeviceAttributeMultiprocessorCount, dev);
        if (hipFuncSetAttribute((const void*)fwd_mega, hipFuncAttributeMaxDynamicSharedMemorySize, LDS_BYTES) != hipSuccess) { fprintf(stderr, "kernel_launch: hipFuncSetAttribute failed\n"); grid = -1; return; }
        if (hipOccupancyMaxActiveBlocksPerMultiprocessor(&per_cu, (const void*)fwd_mega, NTHR, LDS_BYTES) != hipSuccess || per_cu < 1) { fprintf(stderr, "kernel_launch: occupancy query says %d\n", per_cu); per_cu = 1; }
        (void)hipGetLastError();
        grid = cus * (per_cu > 1 ? 1 : per_cu);
    }
    if (grid < 0) return;
    if (hipMemsetAsync((char*)d_ws + WS_BAR, 0, 16384, stream) != hipSuccess) { fprintf(stderr, "kernel_launch: memset of the barrier words failed\n"); return; }
    Args a{};
    a.x = (const float*)d_in[0]; a.c = (const float*)d_in[1]; a.w_ada = (const float*)d_in[2]; a.b_ada = (const float*)d_in[3]; a.norm_mix = (const float*)d_in[4];
    a.w_in = (const float*)d_in[5]; a.norm_a_out = (const float*)d_in[6]; a.norm_c_out = (const float*)d_in[7]; a.w_pool = (const float*)d_in[8]; a.pool_scale = (const float*)d_in[9];
    a.rpb = (const float*)d_in[10]; a.w_out = (const float*)d_in[11]; a.norm_ffn = (const float*)d_in[12]; a.w_ffn_in = (const float*)d_in[13]; a.w_ffn_out = (const float*)d_in[14];
    a.norm_final = (const float*)d_in[15]; a.out = (float*)d_out; a.ws = (unsigned char*)d_ws;
#if MK_PER_PHASE
    for (int ph = 0; ph < N_PHASES; ++ph) { a.ph_lo = ph; a.ph_hi = ph + 1; void* args[] = {&a};
        hipError_t e = hipLaunchCooperativeKernel((const void*)fwd_mega, dim3(grid), dim3(NTHR), args, LDS_BYTES, stream);
        if (e != hipSuccess) { fprintf(stderr, "launch %d failed: %s\n", ph, hipGetErrorString(e)); break; } }
#else
    a.ph_lo = 0; a.ph_hi = N_PHASES; void* args[] = {&a};
    hipError_t e = hipLaunchCooperativeKernel((const void*)fwd_mega, dim3(grid), dim3(NTHR), args, LDS_BYTES, stream);
    if (e != hipSuccess) fprintf(stderr, "cooperative launch failed: %s (grid %d)\n", hipGetErrorString(e), grid);
#endif
}
```

```cpp
#include <hip/hip_runtime.h>
#include <hip/hip_cooperative_groups.h>
#include <cstdio>
#include <cstdint>
namespace cg = cooperative_groups;
#ifndef MK_PER_PHASE
#define MK_PER_PHASE 0
#endif
namespace pg8 {
#define PG8_LAS __attribute__((address_space(3)))
typedef unsigned short bf16_t;
typedef short bf16x8 __attribute__((ext_vector_type(8)));
typedef float f32x4 __attribute__((ext_vector_type(4)));
typedef unsigned u32x4 __attribute__((ext_vector_type(4)));
constexpr int BM = 256, BK = 64, HALF = 128, HTB = HALF * BK * 2  , STAGE_BYTES = 8 * HTB, NXCD = 8, WGM = 8;

__host__ __device__ __forceinline__ int lds_byte(int r, int c) { const int st = (r >> 4) * 2 + (c >> 5), rr = r & 15, cc = c & 31, ob = rr * 64 + cc * 2; return st * 1024 + (ob ^ (((ob >> 9) & 1) << 5)); }
__host__ __device__ __forceinline__ void stage_rc(int b, int& R, int& C) { const int st = b / 1024, sb = b % 1024, swz = sb ^ (((sb >> 9) & 1) << 5); R = (st >> 1) * 16 + swz / 64; C = (st & 1) * 32 + (swz % 64) / 2; }
__host__ __device__ __forceinline__ int perm32(int rho) { const int n = rho >> 4, i = rho & 15; return 8 * (i >> 2) + 4 * n + (i & 3); }

struct Unit { int pm, pn; };
struct Gemm { const bf16_t* A; const bf16_t* Bt; int M, N, K; size_t agap; };

struct StaticOrder {
    int nM, nN, nwg, G, c;
    __host__ __device__ void init(int M, int N, int G_, int c_) { nM = M / BM; nN = N / BM; nwg = nM * nN; G = G_; c = c_; }
    __host__ __device__ bool next(int i, Unit& u) const {
        const long L = (long)i * G + c; if (L >= nwg) return false;
        int wgid = (int)L; { const int q = nwg / NXCD, r = nwg % NXCD, xcd = wgid % NXCD, off = wgid / NXCD; wgid = (xcd < r ? xcd * (q + 1) : r * (q + 1) + (xcd - r) * q) + off; }
        const int nig = WGM * nN, gid = wgid / nig, fm = gid * WGM, gsz = (nM - fm) < WGM ? (nM - fm) : WGM;
        u.pm = fm + ((wgid % nig) % gsz); u.pn = (wgid % nig) / gsz; return true;
    }
    __device__ __forceinline__ void a_ready(const Unit&) const {}
    __device__ __forceinline__ void done(const Unit&) const {}
};

__device__ __forceinline__ unsigned cvt_pk_bf16(float lo, float hi) { unsigned r; asm volatile("v_cvt_pk_bf16_f32 %0, %1, %2" : "=v"(r) : "v"(lo), "v"(hi)); return r; }
typedef float f32x2 __attribute__((ext_vector_type(2)));
typedef unsigned u32x2 __attribute__((ext_vector_type(2)));
__device__ __forceinline__ float silu_f(float g) { return g * __builtin_amdgcn_rcpf(1.0f + __builtin_amdgcn_exp2f(-1.4426950408889634f * g)); }
struct EpiZH {
    static constexpr bool PERM = true, AFTER_DRAIN = false;
    static constexpr size_t SEG = (size_t)6 * 4096 * 64, BLK = (size_t)14 << 20;
    bf16_t* Zh;
    __device__ __forceinline__ void operator()(const f32x4 (&acc)[2][2][4][2], const Unit& u, int wr, int wc, int fr, int fq) const {
        const int m0 = u.pm * BM, b = m0 >> 12, t0 = (m0 & 4095) + wr * 64 + fr;
#pragma unroll
        for (int bj = 0; bj < 2; ++bj) {
            const int colw = u.pn * BM + bj * HALF + wc * 32;
            bf16_t* dst; int ld; float qs = 1.0f;
            if (colw >= 1152 && colw < 1408) { dst = Zh + (size_t)b * BLK + 6 * SEG + (colw - 1152) + 8 * fq; ld = 256; }
            else { const int cc = colw < 1152 ? colw : colw - 1408, seg = (colw < 1152 ? 0 : 3) + cc / 384, rem = cc % 384, h = rem >> 6, d0 = rem & 63;
                   dst = Zh + (size_t)b * BLK + (size_t)seg * SEG + (size_t)h * 4096 * 64 + d0 + 8 * fq; ld = 64; qs = (seg == 0 || seg == 3) ? 0.125f * 1.4426950408889634f : 1.0f; }
#pragma unroll
            for (int ai = 0; ai < 2; ++ai)
#pragma unroll
                for (int m = 0; m < 4; ++m) { const f32x4 v0 = acc[ai][bj][m][0] * qs, v1 = acc[ai][bj][m][1] * qs;
                    u32x4 w; w.x = cvt_pk_bf16(v0[0], v0[1]); w.y = cvt_pk_bf16(v0[2], v0[3]); w.z = cvt_pk_bf16(v1[0], v1[1]); w.w = cvt_pk_bf16(v1[2], v1[3]);
                    *(u32x4*)(dst + (size_t)(t0 + ai * HALF + m * 16) * ld) = w; } }
    }
};
struct EpiSwiGLU {
    static constexpr bool PERM = true, AFTER_DRAIN = false;
    bf16_t* O; int ldc; size_t ogap;
    __device__ __forceinline__ void operator()(const f32x4 (&acc)[2][2][4][2], const Unit& u, int wr, int wc, int fr, int fq) const {
        const int row0 = u.pm * BM + wr * 64 + fr, col0 = u.pn * HALF + wc * 32 + 8 * fq;
#pragma unroll
        for (int ai = 0; ai < 2; ++ai)
#pragma unroll
            for (int m = 0; m < 4; ++m) { bf16_t* rowp = O + (size_t)(row0 + ai * HALF + m * 16) * ldc + (size_t)(u.pm >> 4) * ogap + col0;
                const f32x4 g0 = acc[ai][0][m][0], g1 = acc[ai][0][m][1], u0 = acc[ai][1][m][0], u1 = acc[ai][1][m][1];
                u32x4 w; w.x = cvt_pk_bf16(silu_f(g0[0]) * u0[0], silu_f(g0[1]) * u0[1]); w.y = cvt_pk_bf16(silu_f(g0[2]) * u0[2], silu_f(g0[3]) * u0[3]);
                w.z = cvt_pk_bf16(silu_f(g1[0]) * u1[0], silu_f(g1[1]) * u1[1]); w.w = cvt_pk_bf16(silu_f(g1[2]) * u1[2], silu_f(g1[3]) * u1[3]);
                *(u32x4*)rowp = w; }
    }
};
template <bool BASE_F32>
struct EpiResid {
    static constexpr bool PERM = true, AFTER_DRAIN = false;
    const void* base; bf16_t* out; const float* gate;
    __device__ __forceinline__ void operator()(const f32x4 (&acc)[2][2][4][2], const Unit& u, int wr, int wc, int fr, int fq) const {
        const int row0 = u.pm * BM + wr * 64 + fr, col0 = u.pn * BM + wc * 32 + 8 * fq;
        const float* gp = gate + (size_t)(u.pm >> 4) * 6144 + col0;
        f32x4 gv[2][2];
#pragma unroll
        for (int bj = 0; bj < 2; ++bj)
#pragma unroll
            for (int n = 0; n < 2; ++n) gv[bj][n] = *(const f32x4*)(gp + bj * HALF + n * 4);
        constexpr int MB = BASE_F32 ? 1 : 4;
#pragma unroll
        for (int ai = 0; ai < 2; ++ai)
#pragma unroll
            for (int mb = 0; mb < 4; mb += MB) {
                f32x4 bl[MB][2][2]; u32x4 bw[MB][2];
#pragma unroll
                for (int mi = 0; mi < MB; ++mi) { const size_t off = (size_t)(row0 + ai * HALF + (mb + mi) * 16) * 1024 + col0;
#pragma unroll
                    for (int bj = 0; bj < 2; ++bj) {
                        if (BASE_F32) { bl[mi][bj][0] = *(const f32x4*)((const float*)base + off + bj * HALF); bl[mi][bj][1] = *(const f32x4*)((const float*)base + off + bj * HALF + 4); }
                        else bw[mi][bj] = *(const u32x4*)((const bf16_t*)base + off + bj * HALF); } }
#pragma unroll
                for (int mi = 0; mi < MB; ++mi) { const int m = mb + mi; const size_t off = (size_t)(row0 + ai * HALF + m * 16) * 1024 + col0;
#pragma unroll
                    for (int bj = 0; bj < 2; ++bj) { f32x4 b0, b1;
                        if (BASE_F32) { b0 = bl[mi][bj][0]; b1 = bl[mi][bj][1]; }
                        else { const u32x4 w = bw[mi][bj];
                               b0 = (f32x4){__builtin_bit_cast(float, w.x << 16), __builtin_bit_cast(float, w.x & 0xffff0000u), __builtin_bit_cast(float, w.y << 16), __builtin_bit_cast(float, w.y & 0xffff0000u)};
                               b1 = (f32x4){__builtin_bit_cast(float, w.z << 16), __builtin_bit_cast(float, w.z & 0xffff0000u), __builtin_bit_cast(float, w.w << 16), __builtin_bit_cast(float, w.w & 0xffff0000u)}; }
                        const f32x4 o0 = b0 + gv[bj][0] * acc[ai][bj][m][0], o1 = b1 + gv[bj][1] * acc[ai][bj][m][1];
                        u32x4 r; r.x = cvt_pk_bf16(o0[0], o0[1]); r.y = cvt_pk_bf16(o0[2], o0[3]); r.z = cvt_pk_bf16(o1[0], o1[1]); r.w = cvt_pk_bf16(o1[2], o1[3]);
                        *(u32x4*)(out + off + bj * HALF) = r; } }
                asm volatile("" ::: "memory"); }
    }
};
template <class Epi, class Sched, bool ALIGN_EPI = false, bool SP2 = false>
__device__ __forceinline__ void gemm_phase(PG8_LAS unsigned char* lds, const Gemm g, const Sched& S, const Epi& E, const int tid) {
    const int wid = __builtin_amdgcn_readfirstlane(tid >> 6), lane = tid & 63, wr = wid >> 2, wc = wid & 3, fr = lane & 15, fq = lane >> 4;
    const int K = g.K, nt = K / BK;
    unsigned voffA[2], voffB[2];
#pragma unroll
    for (int i = 0; i < 2; ++i) { int R, C; stage_rc(tid * 16 + i * 8192, R, C); const int Rb = Epi::PERM ? ((R & ~31) + perm32(R & 31)) : R;
        voffA[i] = (unsigned)(R * K + C) * 2u; voffB[i] = (unsigned)(Rb * K + C) * 2u; }
    const size_t kstep = (size_t)(BK * 2);
    const size_t hstep = (size_t)HALF * K * 2;
    const size_t tstep = 2 * hstep;
    const unsigned ldsw = (unsigned)wid * 1024u;
    const int aoff = lds_byte(wr * 64 + fr, fq * 8), boff = lds_byte(wc * 32 + fr, fq * 8);
#define PG8_SA(b, h) (((b) * 2 + (h)) * HTB)
#define PG8_SB(b, h) ((4 + (b) * 2 + (h)) * HTB)
#define PG8_STAGE(bufoff, gbase, voff) do { _Pragma("unroll") for (int _i = 0; _i < 2; ++_i) \
        __builtin_amdgcn_global_load_lds((const unsigned*)((const char*)(gbase) + (voff)[_i]), (PG8_LAS unsigned*)(lds + (bufoff) + ldsw + _i * 8192), 16, 0, 0); } while (0)
#define PG8_LDA(dst, b, h) do { _Pragma("unroll") for (int m = 0; m < 4; ++m) _Pragma("unroll") for (int k = 0; k < 2; ++k) dst[m][k] = *(const PG8_LAS bf16x8*)(lds + PG8_SA(b, h) + aoff + m * 2048 + k * 1024); } while (0)
#define PG8_LDB(dst, b, h) do { _Pragma("unroll") for (int n = 0; n < 2; ++n) _Pragma("unroll") for (int k = 0; k < 2; ++k) dst[n][k] = *(const PG8_LAS bf16x8*)(lds + PG8_SB(b, h) + boff + n * 2048 + k * 1024); } while (0)
#define PG8_MMA(ai, bj, At, Bt) do { __builtin_amdgcn_s_setprio(1); _Pragma("unroll") for (int m = 0; m < 4; ++m) _Pragma("unroll") for (int n = 0; n < 2; ++n) _Pragma("unroll") for (int k = 0; k < 2; ++k) \
        acc[ai][bj][m][n] = __builtin_amdgcn_mfma_f32_16x16x32_bf16(Bt[n][k], At[m][k], acc[ai][bj][m][n], 0, 0, 0); __builtin_amdgcn_s_setprio(0); } while (0)
#define PG8_WAIT_V(n) asm volatile("s_waitcnt vmcnt(" #n ")" ::: "memory")
#define PG8_WAIT_L(n) asm volatile("s_waitcnt lgkmcnt(" #n ")" ::: "memory")
#define PG8_BAR __builtin_amdgcn_s_barrier()
#define PG8_SCHED __builtin_amdgcn_sched_barrier(0)
    Unit cur, nxt; int ui = 0;
    if (!S.next(0, cur)) return;
    f32x4 acc[2][2][4][2];
#pragma unroll
    for (int a = 0; a < 2; ++a)
#pragma unroll
        for (int b = 0; b < 2; ++b)
#pragma unroll
            for (int m = 0; m < 4; ++m)
#pragma unroll
                for (int n = 0; n < 2; ++n) acc[a][b][m][n] = (f32x4){0.f, 0.f, 0.f, 0.f};
    bf16x8 At[4][2], B0[2][2], B1[2][2];
    const char* cA = (const char*)g.A + (size_t)cur.pm * tstep + (size_t)(cur.pm >> 4) * g.agap * 2; const char* cB = (const char*)g.Bt + (size_t)cur.pn * tstep;
    S.a_ready(cur);
    if constexpr (SP2) {
        PG8_STAGE(PG8_SB(0, 0), cB, voffB); PG8_STAGE(PG8_SB(0, 1), cB + hstep, voffB); PG8_STAGE(PG8_SA(0, 0), cA, voffA); PG8_STAGE(PG8_SA(0, 1), cA + hstep, voffA);
        if (wr == 1) PG8_BAR;
        PG8_WAIT_V(2); PG8_BAR;
        PG8_STAGE(PG8_SB(1, 0), cB + kstep, voffB); PG8_STAGE(PG8_SA(1, 0), cA + kstep, voffA); PG8_STAGE(PG8_SB(1, 1), cB + hstep + kstep, voffB);
        PG8_WAIT_V(6); PG8_BAR;
    } else {
        PG8_STAGE(PG8_SB(0, 0), cB, voffB); PG8_STAGE(PG8_SA(0, 0), cA, voffA); PG8_STAGE(PG8_SB(0, 1), cB + hstep, voffB); PG8_STAGE(PG8_SA(0, 1), cA + hstep, voffA);
        if (wr == 1) PG8_BAR;
        PG8_WAIT_V(4); PG8_BAR;
        PG8_STAGE(PG8_SB(1, 0), cB + kstep, voffB); PG8_STAGE(PG8_SA(1, 0), cA + kstep, voffA); PG8_STAGE(PG8_SB(1, 1), cB + hstep + kstep, voffB);
        PG8_WAIT_V(6); PG8_BAR;
    }
    for (;;) {
        const bool has_next = S.next(ui + 1, nxt);
        const char* nA = has_next ? (const char*)g.A + (size_t)nxt.pm * tstep + (size_t)(nxt.pm >> 4) * g.agap * 2 : cA; const char* nB = has_next ? (const char*)g.Bt + (size_t)nxt.pn * tstep : cB;
        for (int t = 0; t < nt; t += 2) {
            const bool last = (t == nt - 2);
            const char* a1 = cA + (size_t)(t + 1) * kstep;
            const char* a2 = last ? nA : cA + (size_t)(t + 2) * kstep; const char* b2 = last ? nB : cB + (size_t)(t + 2) * kstep;
            const char* a3 = a2 + kstep; const char* b3 = b2 + kstep;
            if (last && has_next) S.a_ready(nxt);
            if constexpr (SP2) {
            PG8_LDB(B0, 0, 0); PG8_LDB(B1, 0, 1); PG8_SCHED; PG8_LDA(At, 0, 0); PG8_STAGE(PG8_SA(1, 1), a1 + hstep, voffA);
            PG8_WAIT_V(8); PG8_WAIT_L(0); PG8_BAR; PG8_MMA(0, 0, At, B0); PG8_MMA(0, 1, At, B1); PG8_BAR; PG8_SCHED;
            PG8_LDA(At, 0, 1); PG8_STAGE(PG8_SB(0, 0), b2, voffB); PG8_STAGE(PG8_SB(0, 1), b2 + hstep, voffB); PG8_STAGE(PG8_SA(0, 0), a2, voffA);
            PG8_WAIT_V(8); PG8_WAIT_L(0); PG8_BAR; PG8_MMA(1, 0, At, B0); PG8_MMA(1, 1, At, B1); PG8_BAR; PG8_SCHED;
            PG8_LDB(B0, 1, 0); PG8_LDB(B1, 1, 1); PG8_SCHED; PG8_LDA(At, 1, 0); PG8_STAGE(PG8_SA(0, 1), a2 + hstep, voffA);
            PG8_WAIT_V(8); PG8_WAIT_L(0); PG8_BAR; PG8_MMA(0, 0, At, B0); PG8_MMA(0, 1, At, B1); PG8_BAR; PG8_SCHED;
            PG8_LDA(At, 1, 1); PG8_STAGE(PG8_SB(1, 0), b3, voffB); PG8_STAGE(PG8_SB(1, 1), b3 + hstep, voffB); PG8_STAGE(PG8_SA(1, 0), a3, voffA);
            PG8_WAIT_V(8); PG8_WAIT_L(0); PG8_BAR; PG8_MMA(1, 0, At, B0); PG8_MMA(1, 1, At, B1); PG8_BAR; PG8_SCHED;
            } else {
            PG8_LDB(B0, 0, 0); PG8_SCHED; PG8_LDA(At, 0, 0); PG8_STAGE(PG8_SA(1, 1), a1 + hstep, voffA);
            PG8_WAIT_L(8); PG8_BAR; PG8_WAIT_L(0); PG8_MMA(0, 0, At, B0); PG8_BAR; PG8_SCHED;
            PG8_LDB(B1, 0, 1); PG8_STAGE(PG8_SB(0, 0), b2, voffB);
            PG8_BAR; PG8_WAIT_L(0); PG8_MMA(0, 1, At, B1); PG8_BAR;
            PG8_LDA(At, 0, 1); PG8_STAGE(PG8_SA(0, 0), a2, voffA);
            PG8_BAR; PG8_WAIT_L(0); PG8_MMA(1, 0, At, B0); PG8_BAR; PG8_SCHED;
            PG8_STAGE(PG8_SB(0, 1), b2 + hstep, voffB);
            PG8_WAIT_V(6); PG8_BAR; PG8_MMA(1, 1, At, B1); PG8_BAR;
            PG8_LDB(B0, 1, 0); PG8_SCHED; PG8_LDA(At, 1, 0); PG8_STAGE(PG8_SA(0, 1), a2 + hstep, voffA);
            PG8_WAIT_L(8); PG8_BAR; PG8_WAIT_L(0); PG8_MMA(0, 0, At, B0); PG8_BAR; PG8_SCHED;
            PG8_LDB(B1, 1, 1); PG8_STAGE(PG8_SB(1, 0), b3, voffB);
            PG8_BAR; PG8_WAIT_L(0); PG8_MMA(0, 1, At, B1); PG8_BAR;
            PG8_LDA(At, 1, 1); PG8_STAGE(PG8_SA(1, 0), a3, voffA);
            PG8_BAR; PG8_WAIT_L(0); PG8_MMA(1, 0, At, B0); PG8_BAR; PG8_SCHED;
            PG8_STAGE(PG8_SB(1, 1), b3 + hstep, voffB);
            PG8_WAIT_V(6); PG8_BAR; PG8_MMA(1, 1, At, B1); PG8_BAR;
            }
        }
        if constexpr (ALIGN_EPI) { if (wr == 0) PG8_BAR; }
        if constexpr (!Epi::AFTER_DRAIN) { E(acc, cur, wr, wc, fr, fq); S.done(cur); }
        if (!has_next) break;
#pragma unroll
        for (int a = 0; a < 2; ++a)
#pragma unroll
            for (int b = 0; b < 2; ++b)
#pragma unroll
                for (int m = 0; m < 4; ++m)
#pragma unroll
                    for (int n = 0; n < 2; ++n) acc[a][b][m][n] = (f32x4){0.f, 0.f, 0.f, 0.f};
        cur = nxt; cA = nA; cB = nB; ++ui;
        if constexpr (ALIGN_EPI) { if (wr == 1) PG8_BAR; }
    }
    PG8_WAIT_V(0);
    if constexpr (!ALIGN_EPI) { if (wr == 0) PG8_BAR; }
    PG8_BAR;
    if constexpr (Epi::AFTER_DRAIN) { E.fused(acc, cur, wr, wc, fr, fq, lds, wid, lane); S.done(cur); }
#undef PG8_SA
#undef PG8_SB
#undef PG8_STAGE
#undef PG8_LDA
#undef PG8_LDB
#undef PG8_MMA
#undef PG8_WAIT_V
#undef PG8_WAIT_L
#undef PG8_BAR
#undef PG8_SCHED
}
}

#define LAS __attribute__((address_space(3)))
typedef unsigned short bf16_t;
typedef short bf16x8 __attribute__((ext_vector_type(8)));
typedef short s16x4 __attribute__((ext_vector_type(4)));
typedef float f32x4 __attribute__((ext_vector_type(4)));
typedef float f32x16 __attribute__((ext_vector_type(16)));
typedef unsigned u32x4 __attribute__((ext_vector_type(4)));
typedef unsigned u32x2 __attribute__((ext_vector_type(2)));

constexpr int NWAVES = 8, NTHR = 512;
constexpr int NB = 8, SEQ = 4096, DM = 1024, MTOK = NB * SEQ, PW = 2560, FF = 2816, NLAYER = 2;
constexpr int LDS_BYTES = 163840;
constexpr int LDS_XB_OFF = 159744;
constexpr float EPS = 1e-6f, LOG2E = 1.4426950408889634f, LN2 = 0.6931471805599453f;
constexpr size_t MiB = 1u << 20;
constexpr size_t WS_MOD = 0;
constexpr size_t WS_BAR = 512 * 1024;
constexpr size_t WS_W = 1 * MiB, W_LAYER = 24 * MiB;
constexpr size_t W_IN = 0, W_OUT = 5 * MiB, W_FI = 7 * MiB, W_FO = 18 * MiB;
constexpr size_t WS_H = 49 * MiB;
constexpr size_t WS_Z = 113 * MiB;
constexpr size_t BLK_E = (size_t)14 * MiB;
constexpr size_t ZSEG = (size_t)6 * 4096 * 64;
constexpr size_t UB_OFF_E = 6 * ZSEG;
constexpr size_t MIX_OFF_E = (size_t)10 * MiB;
constexpr size_t MIX_GAP_E = BLK_E - (size_t)4096 * 1024;
constexpr size_t ACT_GAP_E = BLK_E - (size_t)4096 * 2816;
constexpr size_t WS_OBR = 337 * MiB, OBR_STRIDE = 24 * MiB;
constexpr size_t WS_LSE = 433 * MiB;
constexpr size_t WS_X = 440 * MiB;
constexpr size_t WS_END = 504 * MiB;
static_assert(WS_Z + 8 * BLK_E * 2 <= WS_OBR && UB_OFF_E + (size_t)4096 * 256 <= MIX_OFF_E && MIX_OFF_E + (size_t)4096 * 1024 <= BLK_E && (size_t)4096 * 2816 <= BLK_E && W_FO + (size_t)DM * FF * 2 <= W_LAYER, "ws map");

__device__ __forceinline__ float wave_sum(float v) {
#pragma unroll
    for (int o = 1; o < 64; o <<= 1) v += __shfl_xor(v, o);
    return v;
}
__device__ __forceinline__ unsigned f2bf(float f) { unsigned u = __builtin_bit_cast(unsigned, f); return (u + 0x7fffu + ((u >> 16) & 1u)) >> 16; }
__device__ __forceinline__ unsigned pk2(float lo, float hi) { return f2bf(lo) | (f2bf(hi) << 16); }
__device__ __forceinline__ float bf_lo(unsigned w) { return __builtin_bit_cast(float, w << 16); }
__device__ __forceinline__ float bf_hi(unsigned w) { return __builtin_bit_cast(float, w & 0xffff0000u); }
#define LDS_WAIT() asm volatile("s_waitcnt lgkmcnt(0)" ::: "memory")

struct Args {
    const float *x, *c, *w_ada, *b_ada, *norm_mix, *w_in, *norm_a_out, *norm_c_out, *w_pool, *pool_scale, *rpb, *w_out, *norm_ffn, *w_ffn_in, *w_ffn_out, *norm_final;
    float* out; unsigned char* ws; int ph_lo, ph_hi;
};

template <bool SWG>
__device__ __forceinline__ void transpose_item(const float* W, int K, int N, bf16_t* WT, LAS float* scr, int item, int lane) {
    const int nblk = N / 32, kb = item / nblk, nb = item % nblk, k0 = 64 * kb, n0 = 32 * nb;
    int d0 = n0;
    if (SWG) { const int bj = n0 / FF, j = n0 % FF; d0 = 256 * (j / 128) + 128 * bj + (j % 128); }
    float tv[32];
#pragma unroll
    for (int i = 0; i < 32; ++i) tv[i] = W[(size_t)(k0 + 2 * i + (lane >> 5)) * N + n0 + (lane & 31)];
#pragma unroll
    for (int i = 0; i < 32; ++i) scr[(2 * i + (lane >> 5)) * 33 + (lane & 31)] = tv[i];
    LDS_WAIT();
    const int c = lane & 7;
#pragma unroll
    for (int j = 0; j < 4; ++j) { const int n = (lane >> 3) + 8 * j; const LAS float* s = scr + (8 * c) * 33 + n;
        u32x4 o; o.x = pk2(s[0 * 33], s[1 * 33]); o.y = pk2(s[2 * 33], s[3 * 33]); o.z = pk2(s[4 * 33], s[5 * 33]); o.w = pk2(s[6 * 33], s[7 * 33]);
        *(u32x4*)(WT + (size_t)(d0 + n) * K + k0 + 8 * c) = o; }
    LDS_WAIT();
}

__device__ __forceinline__ void phase_p0(const Args& a, LAS unsigned char* lds, int tid, int lane, int wave) {
    float* mod = (float*)(a.ws + WS_MOD);
    for (int item = blockIdx.x; item < 192; item += gridDim.x) {
        LAS float* sc = (LAS float*)lds;
        LAS float* red = (LAS float*)(lds + 32768);
        for (int i = tid; i < 8192; i += NTHR) { const float v = a.c[i]; sc[(i & 1023) * 8 + (i >> 10)] = v / (1.0f + __expf(-v)); }
        __syncthreads();
        const int l = item / 96, cb = item % 96, col = cb * 64 + lane;
        const float* wp = a.w_ada + (size_t)l * DM * 6144 + (size_t)(wave * 128) * 6144 + col;
        float acc0 = 0.f, acc1 = 0.f, acc2 = 0.f, acc3 = 0.f, acc4 = 0.f, acc5 = 0.f, acc6 = 0.f, acc7 = 0.f;
#pragma unroll 16
        for (int k = 0; k < 128; ++k) {
            const float w = wp[(size_t)k * 6144];
            const f32x4 s0 = *(const LAS f32x4*)(sc + (wave * 128 + k) * 8), s1 = *(const LAS f32x4*)(sc + (wave * 128 + k) * 8 + 4);
            acc0 += w * s0[0]; acc1 += w * s0[1]; acc2 += w * s0[2]; acc3 += w * s0[3]; acc4 += w * s1[0]; acc5 += w * s1[1]; acc6 += w * s1[2]; acc7 += w * s1[3];
        }
        red[(wave * 8 + 0) * 64 + lane] = acc0; red[(wave * 8 + 1) * 64 + lane] = acc1; red[(wave * 8 + 2) * 64 + lane] = acc2; red[(wave * 8 + 3) * 64 + lane] = acc3;
        red[(wave * 8 + 4) * 64 + lane] = acc4; red[(wave * 8 + 5) * 64 + lane] = acc5; red[(wave * 8 + 6) * 64 + lane] = acc6; red[(wave * 8 + 7) * 64 + lane] = acc7;
        __syncthreads();
        { const int b = wave; float s = 0.f;
#pragma unroll
          for (int w = 0; w < 8; ++w) s += red[(w * 8 + b) * 64 + lane];
          mod[((size_t)l * NB + b) * 6144 + col] = s + a.b_ada[(size_t)l * 6144 + col]; }
        __syncthreads();
    }
    LAS float* scr = (LAS float*)(lds + wave * 16384);
    const int gw = blockIdx.x * NWAVES + wave, NGW = gridDim.x * NWAVES;
    constexpr int I_IN = (DM / 64) * (PW / 32), I_OUT = (DM / 64) * (DM / 32), I_FI = (DM / 64) * (2 * FF / 32), I_FO = (FF / 64) * (DM / 32), I_L = I_IN + I_OUT + I_FI + I_FO;
    for (int it = gw; it < NLAYER * I_L; it += NGW) {
        const int l = it / I_L; int r = it % I_L;
        unsigned char* wl = a.ws + WS_W + (size_t)l * W_LAYER;
        if (r < I_IN) { transpose_item<false>(a.w_in + (size_t)l * DM * PW, DM, PW, (bf16_t*)(wl + W_IN), scr, r, lane); continue; } r -= I_IN;
        if (r < I_OUT) { transpose_item<false>(a.w_out + (size_t)l * DM * DM, DM, DM, (bf16_t*)(wl + W_OUT), scr, r, lane); continue; } r -= I_OUT;
        if (r < I_FI) { transpose_item<true>(a.w_ffn_in + (size_t)l * DM * 2 * FF, DM, 2 * FF, (bf16_t*)(wl + W_FI), scr, r, lane); continue; } r -= I_FI;
        transpose_item<false>(a.w_ffn_out + (size_t)l * FF * DM, FF, DM, (bf16_t*)(wl + W_FO), scr, r, lane);
    }
}

template <bool FINAL>
__device__ __forceinline__ void norm_rows(const float* X, const float* g, const float* sc, const float* sh, bf16_t* H, float* outF, int gw, int NGW, int lane) {
    for (int cj = 0; 16 * (gw + NGW * (cj >> 3)) < MTOK; ++cj) {
        const int m = 16 * (gw + NGW * (cj >> 3)) + 2 * (cj & 7);
        const f32x4* xr = (const f32x4*)(X + (size_t)m * DM) + lane;
        f32x4 v[2][4]; float s0 = 0.f, s1 = 0.f;
#pragma unroll
        for (int j = 0; j < 4; ++j) { v[0][j] = xr[64 * j]; v[1][j] = xr[256 + 64 * j]; }
#pragma unroll
        for (int j = 0; j < 4; ++j) { s0 += (v[0][j][0] * v[0][j][0] + v[0][j][1] * v[0][j][1]) + (v[0][j][2] * v[0][j][2] + v[0][j][3] * v[0][j][3]);
                                      s1 += (v[1][j][0] * v[1][j][0] + v[1][j][1] * v[1][j][1]) + (v[1][j][2] * v[1][j][2] + v[1][j][3] * v[1][j][3]); }
        const float rstd0 = 1.0f / sqrtf(wave_sum(s0) * (1.0f / DM) + EPS), rstd1 = 1.0f / sqrtf(wave_sum(s1) * (1.0f / DM) + EPS);
        const int b = m >> 12;
#pragma unroll
        for (int j = 0; j < 4; ++j) { const int col = 4 * lane + 256 * j; const f32x4 gv = *(const f32x4*)(g + col);
            f32x4 y0 = v[0][j] * rstd0 * gv, y1 = v[1][j] * rstd1 * gv;
            if (FINAL) { *(f32x4*)(outF + (size_t)m * DM + col) = y0; *(f32x4*)(outF + (size_t)(m + 1) * DM + col) = y1; }
            else { const f32x4 scv = *(const f32x4*)(sc + (size_t)b * 6144 + col) + 1.0f, shv = *(const f32x4*)(sh + (size_t)b * 6144 + col);
                y0 = y0 * scv + shv; y1 = y1 * scv + shv; u32x2 w0, w1; w0.x = pk2(y0[0], y0[1]); w0.y = pk2(y0[2], y0[3]); w1.x = pk2(y1[0], y1[1]); w1.y = pk2(y1[2], y1[3]);
                *(u32x2*)(H + (size_t)m * DM + col) = w0; *(u32x2*)(H + (size_t)(m + 1) * DM + col) = w1; } }
    }
}


template <bool FINAL>
__device__ __forceinline__ void norm_rows_bf(const bf16_t* X, const float* g, const float* sc, const float* sh, bf16_t* H, float* outF, int gw, int NGW, int lane) {
    constexpr int NR = 4;
    u32x4 raw[NR][2], nxt[NR][2];
    static_assert(NR == 4, "row chunking below assumes 4 rows per iteration");
#define NRB_ROW(cj_) (16 * (gw + NGW * ((cj_) >> 2)) + NR * ((cj_) & 3))
    { const int m = NRB_ROW(0); if (m < MTOK) { const u32x4* xr = (const u32x4*)(X + (size_t)m * DM) + lane;
#pragma unroll
        for (int r = 0; r < NR; ++r) { raw[r][0] = xr[128 * r]; raw[r][1] = xr[128 * r + 64]; } } }
    for (int cj = 0; NRB_ROW(cj) < MTOK; ++cj) {
        const int m = NRB_ROW(cj);
        { const int mn = NRB_ROW(cj + 1) < MTOK ? NRB_ROW(cj + 1) : m; const u32x4* xn = (const u32x4*)(X + (size_t)mn * DM) + lane;
#pragma unroll
          for (int r = 0; r < NR; ++r) { nxt[r][0] = xn[128 * r]; nxt[r][1] = xn[128 * r + 64]; } }
        float ss[NR];
#pragma unroll
        for (int r = 0; r < NR; ++r) { ss[r] = 0.f;
#pragma unroll
            for (int j = 0; j < 2; ++j)
#pragma unroll
                for (int e = 0; e < 4; ++e) { const unsigned w = raw[r][j][e]; const float lo = bf_lo(w), hi = bf_hi(w); ss[r] += lo * lo + hi * hi; } }
        float rstd[NR];
#pragma unroll
        for (int r = 0; r < NR; ++r) rstd[r] = 1.0f / sqrtf(wave_sum(ss[r]) * (1.0f / DM) + EPS);
        const int b = m >> 12;
#pragma unroll
        for (int j = 0; j < 2; ++j) { const int col = 8 * lane + 512 * j;
            float gg[8], aa[8], bb[8];
#pragma unroll
            for (int q = 0; q < 2; ++q) { const f32x4 gv = *(const f32x4*)(g + col + 4 * q);
                f32x4 scv = (f32x4){0.f, 0.f, 0.f, 0.f}, shv = scv;
                if (!FINAL) { scv = *(const f32x4*)(sc + (size_t)b * 6144 + col + 4 * q); shv = *(const f32x4*)(sh + (size_t)b * 6144 + col + 4 * q); }
#pragma unroll
                for (int e = 0; e < 4; ++e) { gg[4 * q + e] = gv[e]; aa[4 * q + e] = 1.0f + scv[e]; bb[4 * q + e] = shv[e]; } }
#pragma unroll
            for (int r = 0; r < NR; ++r) {
                float y[8];
#pragma unroll
                for (int e = 0; e < 4; ++e) { const unsigned w = raw[r][j][e]; y[2 * e] = bf_lo(w) * rstd[r] * gg[2 * e]; y[2 * e + 1] = bf_hi(w) * rstd[r] * gg[2 * e + 1]; }
                if (!FINAL) {
#pragma unroll
                    for (int e = 0; e < 8; ++e) y[e] = y[e] * aa[e] + bb[e]; }
                if (FINAL) { float* o = outF + (size_t)(m + r) * DM + col; *(f32x4*)o = (f32x4){y[0], y[1], y[2], y[3]}; *(f32x4*)(o + 4) = (f32x4){y[4], y[5], y[6], y[7]}; }
                else { u32x4 w; w.x = pk2(y[0], y[1]); w.y = pk2(y[2], y[3]); w.z = pk2(y[4], y[5]); w.w = pk2(y[6], y[7]); *(u32x4*)(H + (size_t)(m + r) * DM + col) = w; } } }
#pragma unroll
        for (int r = 0; r < NR; ++r) { raw[r][0] = nxt[r][0]; raw[r][1] = nxt[r][1]; }
    }
#undef NRB_ROW
}
#define LDS_BARRIER() asm volatile("s_waitcnt lgkmcnt(0)\n\ts_barrier" ::: "memory")
__device__ __forceinline__ void pool_phase(const Args& a, int l, LAS unsigned char* lds, int tid, int vb) {
    const bf16_t* UB = (const bf16_t*)(a.ws + WS_Z) + UB_OFF_E; bf16_t* MIX = (bf16_t*)(a.ws + WS_Z) + MIX_OFF_E;
    constexpr int PLP = 528, WTP = 144;
    LAS bf16_t* us = (LAS bf16_t*)lds;
    LAS unsigned char* plb = lds + 40960;
    LAS unsigned char* wt = lds + 40960 + 64 * PLP;
    static_assert(40960 + 64 * PLP + 256 * WTP <= 131072, "pool LDS map");
    const int G = gridDim.x; const bool xa = (G == 256);
    int unit = xa ? (vb & 7) * 64 + (vb >> 3) : vb; const int ustep = xa ? 32 : G, uend = xa ? (vb & 7) * 64 + 64 : 512;
    if (unit >= uend) return;
    const int c = tid & 255, g = c >> 6, th = tid >> 8, hw = 1 << g;
    const int wave = tid >> 6, lane = tid & 63, r = lane & 31, hh = lane >> 5, mg = wave & 3, mt = wave >> 2;
    { const float* wp = a.w_pool + (size_t)l * 4 * 4096;
      for (int i = tid; i < 4 * 4096; i += NTHR) { const int gg = i >> 12, cc = (i >> 6) & 63, dd = i & 63; *(LAS bf16_t*)(wt + (gg * 64 + dd) * WTP + cc * 2) = (bf16_t)f2bf(wp[i]); } }
    const float psc0 = a.pool_scale[l * 256 + mg * 64 + r], psc1 = a.pool_scale[l * 256 + mg * 64 + 32 + r];
    u32x4 pre[5];
#define POOL_LOAD(unit_) do { const int b_ = (unit_) >> 6, t0_ = ((unit_) & 63) * 64; _Pragma("unroll") for (int i_ = 0; i_ < 5; ++i_) { const int q_ = tid + NTHR * i_, rr_ = q_ >> 5, ch_ = q_ & 31, t_ = t0_ - 8 + rr_; \
        pre[i_] = (u32x4){0u, 0u, 0u, 0u}; if (t_ >= 0 && t_ < SEQ) pre[i_] = *(const u32x4*)(UB + (size_t)b_ * BLK_E + (size_t)t_ * 256 + ch_ * 8); } } while (0)
    POOL_LOAD(unit);
#define US(row_) __builtin_bit_cast(float, (unsigned)us[(row_) * 256 + c] << 16)
    for (; unit < uend; unit += ustep) {
        const int b = unit >> 6, t0 = (unit & 63) * 64;
        LDS_BARRIER();
#pragma unroll
        for (int i = 0; i < 5; ++i) { const int q = tid + NTHR * i, rr = q >> 5, ch = q & 31; *(LAS u32x4*)(us + rr * 256 + ch * 8) = pre[i]; }
        LDS_BARRIER();
        if (unit + ustep < uend) POOL_LOAD(unit + ustep);
        { const int tt0 = th * 32; float s = 0.f;
          for (int q = tt0 + 8 - hw; q <= tt0 + 8 + hw - 1; ++q) s += US(q);
          for (int tt = tt0; tt < tt0 + 32; tt += 4) {
              float av[4], bv[4], cv[4], ic[4];
#pragma unroll
              for (int e = 0; e < 4; ++e) { av[e] = US(tt + e + 8 + hw); bv[e] = US(tt + e + 8 - hw); cv[e] = US(tt + e + 8);
                  const int t = t0 + tt + e; int lo = t - hw; if (lo < 0) lo = 0; int hi = t + hw - 1; if (hi > SEQ - 1) hi = SEQ - 1; ic[e] = __builtin_amdgcn_rcpf((float)(hi - lo + 1)); }
#pragma unroll
              for (int e = 0; e < 4; ++e) { *(LAS bf16_t*)(plb + (tt + e) * PLP + c * 2) = (bf16_t)f2bf(s * ic[e] - cv[e]); s += av[e] - bv[e]; } } }
        LDS_BARRIER();
        {
          const LAS unsigned char* ap = plb + (32 * mt + r) * PLP + (mg * 64 + 8 * hh) * 2;
          const LAS unsigned char* bp = wt + (mg * 64 + r) * WTP + (8 * hh) * 2;
          f32x16 y0, y1;
#pragma unroll
          for (int i = 0; i < 16; ++i) { y0[i] = 0.f; y1[i] = 0.f; }
#pragma unroll
          for (int s4 = 0; s4 < 4; ++s4) { const bf16x8 af = *(const LAS bf16x8*)(ap + 32 * s4), b0 = *(const LAS bf16x8*)(bp + 32 * s4), b1 = *(const LAS bf16x8*)(bp + 32 * WTP + 32 * s4);
              y0 = __builtin_amdgcn_mfma_f32_32x32x16_bf16(af, b0, y0, 0, 0, 0); y1 = __builtin_amdgcn_mfma_f32_32x32x16_bf16(af, b1, y1, 0, 0, 0); }
          bf16_t* op = MIX + (size_t)b * BLK_E + (size_t)(t0 + 32 * mt + 4 * hh) * DM + 384 + mg * 64 + r;
#pragma unroll
          for (int i = 0; i < 16; ++i) { const int tk = (i & 3) + 8 * (i >> 2); op[(size_t)tk * DM] = (bf16_t)f2bf(y0[i] * psc0); op[(size_t)tk * DM + 32] = (bf16_t)f2bf(y1[i] * psc1); } }
    }
#undef US
#undef POOL_LOAD
    __syncthreads();
}

constexpr int VP = 144;
constexpr int KT_OFF = 0, VT_OFF = 384 * VP, RPB_OFF = 2 * 384 * VP, QT_OFF = 121856;
static_assert(RPB_OFF + 6 * 15 * 31 * 4 <= QT_OFF && QT_OFF + 256 * VP <= LDS_XB_OFF, "attention LDS map");
constexpr int BT_OFF = LDS_XB_OFF + 128;
static_assert(BT_OFF + 192 * 4 <= LDS_BYTES, "bias table");
struct PassDesc { int mode, b, h, ls, res, i0, r0, sub; };
#define D_KRLO(d_) rstart_of((d_).r0)
#define D_KRHI(d_) (rstart_of((d_).r0 + 3) + 7)
__device__ __forceinline__ int rstart_of(int r) { int s = r - 4; return s < 0 ? 0 : (s > 56 ? 56 : s); }
__device__ __forceinline__ s16x4 vtr(const LAS unsigned char* p) { return __builtin_bit_cast(s16x4, __builtin_amdgcn_ds_read_tr16_b64_v4i16((LAS s16x4*)p)); }
constexpr int NA_UNITS = 48 * 3 * 16, NC_UNITS = 48 * 16;

__device__ __forceinline__ void get_pass(int s, int nA, PassDesc& d, int vb) {
    const int x = vb & 7, li = vb >> 3, G = gridDim.x; const bool xa = (G == 256);
    d.mode = 0; d.b = 0; d.h = 0; d.ls = 0; d.res = 0; d.i0 = 0; d.r0 = 0; d.sub = 0;
    if (s < nA) { const int ia = xa ? li + 32 * s : vb + s * G, bh = (xa ? 6 * x : 0) + ia / 48, u = ia % 48, br = u >> 4, q = u & 15; d.mode = 0; d.b = bh / 6; d.h = bh % 6; d.ls = 2 * br;
        const int cpr = 16 >> d.ls;
        d.res = q / cpr; d.i0 = (q % cpr) * 256; }
    else { const int c = s - nA, ic = xa ? li + 32 * (c >> 1) : vb + (c >> 1) * G, bh = (xa ? 6 * x : 0) + ic / 16, quad = ic & 15; d.mode = 1; d.b = bh / 6; d.h = bh % 6; d.sub = c & 1; d.r0 = 4 * quad; }
}
__device__ __forceinline__ int pass_qtok(const PassDesc& d, int wave, int lane) {
    const int r = lane & 31;
    return d.mode == 0 ? (((d.i0 + 32 * wave + r) << d.ls) + d.res) : ((d.r0 + 2 * (wave >> 2) + (r >> 4)) * 64 + 16 * (wave & 3) + (r & 15));
}
__device__ __forceinline__ void attn_load_kv(const PassDesc& d, const bf16_t* Z, int tid, u32x4 (&kr)[6], u32x4 (&vr)[6]) {
    const bf16_t* Kb = Z + (size_t)d.b * BLK_E + (size_t)(d.mode == 0 ? 1 : 4) * ZSEG + (size_t)d.h * SEQ * 64;
    const int n = SEQ >> d.ls;
    int tq_ = tid; asm volatile("" : "+v"(tq_));
#pragma unroll
    for (int i = 0; i < 6; ++i) { const int q = tq_ + NTHR * i, row = q >> 3, ch = q & 7; int tok;
        if (d.mode == 0) { int j = d.i0 - 64 + row; j = j < 0 ? 0 : (j > n - 1 ? n - 1 : j); tok = (j << d.ls) + d.res; }
        else { const int krhi_ = D_KRHI(d); int kr_ = D_KRLO(d) + 6 * d.sub + (row >> 6); kr_ = kr_ > krhi_ ? krhi_ : kr_; tok = kr_ * 64 + (row & 63); }
        const bf16_t* p = Kb + tok * 64 + ch * 8; kr[i] = *(const u32x4*)p; vr[i] = *(const u32x4*)(p + ZSEG); }
}
__device__ __forceinline__ void attn_load_q(const PassDesc& d, const bf16_t* Z, int wave, int lane, bf16x8 (&qf)[4]) {
    const bf16_t* qp = Z + (size_t)d.b * BLK_E + (size_t)(d.mode == 0 ? 0 : 3) * ZSEG + ((size_t)d.h * SEQ + pass_qtok(d, wave, lane)) * 64 + 8 * (lane >> 5);
#pragma unroll
    for (int s = 0; s < 4; ++s) qf[s] = *(const bf16x8*)(qp + 16 * s);
}
__device__ __forceinline__ void attn_stage(LAS unsigned char* lds, int tid, const u32x4 (&kr)[6], const u32x4 (&vr)[6], const bf16x8 (&qf)[4]) {
    { const int wave_ = tid >> 6, lane_ = tid & 63; LAS unsigned char* qp_ = lds + QT_OFF + (32 * wave_ + (lane_ & 31)) * VP + 16 * (lane_ >> 5);
#pragma unroll
      for (int s_ = 0; s_ < 4; ++s_) *(LAS bf16x8*)(qp_ + 32 * s_) = qf[s_]; }
    int ts_ = tid; asm volatile("" : "+v"(ts_));
#pragma unroll
    for (int i = 0; i < 6; ++i) { const int q = ts_ + NTHR * i, row = q >> 3, ch = q & 7;
        *(LAS u32x4*)(lds + KT_OFF + row * VP + ch * 16) = kr[i]; *(LAS u32x4*)(lds + VT_OFF + row * VP + ch * 16) = vr[i]; }
}

struct AttnLane { int r, hh, n, qi, rq, cq, cstart, rs, kc0; float slope2, mid, hwid; };

template <int MODE, int NT>
__device__ __forceinline__ void attn_step(const PassDesc& d, const AttnLane& L, LAS unsigned char* lds, const LAS float* rpbl, float& m, float& l, f32x16& o0, f32x16& o1, int wave, int lane, int st) {
    typedef float f32x2 __attribute__((ext_vector_type(2)));
    const int r = L.r, hh = L.hh;
    int rowbase[NT], jb[NT], krow[NT];
#pragma unroll
    for (int t = 0; t < NT; ++t) { rowbase[t] = (MODE == 0) ? 32 * (wave + st + t) : 64 * (st + t) + L.kc0; jb[t] = d.i0 - 64 + rowbase[t]; krow[t] = D_KRLO(d) + 6 * d.sub + st + t; }
    f32x16 sa[NT];
#pragma unroll
    for (int t = 0; t < NT; ++t) { const LAS unsigned char* kp = lds + KT_OFF + (rowbase[t] + r) * VP + 16 * hh; const LAS unsigned char* qp = lds + QT_OFF + (32 * wave + r) * VP + 16 * hh; bf16x8 kf[4], qf[4];
#pragma unroll
        for (int s = 0; s < 4; ++s) { kf[s] = *(const LAS bf16x8*)(kp + 32 * s); qf[s] = *(const LAS bf16x8*)(qp + 32 * s); }
#pragma unroll
        for (int i = 0; i < 16; ++i) sa[t][i] = 0.f;
#pragma unroll
        for (int s = 0; s < 4; ++s) sa[t] = __builtin_amdgcn_mfma_f32_32x32x16_bf16(kf[s], qf[s], sa[t], 0, 0, 0);
        __builtin_amdgcn_sched_barrier(0); }
    float mloc = -1e30f;
#pragma unroll
    for (int t = 0; t < NT; ++t) {
        if (MODE == 0) {
            if (jb[t] >= 0 && jb[t] + 31 < L.n) {
                const LAS float* bp = (const LAS float*)(lds + BT_OFF) + (jb[t] + 4 * hh - L.qi + 95);
                float bias[16];
#pragma unroll
                for (int i = 0; i < 16; ++i) bias[i] = bp[(i & 3) + 8 * (i >> 2)];
#pragma unroll
                for (int i = 0; i < 16; ++i) sa[t][i] += bias[i];
            } else {
            const float rel0 = (float)(jb[t] + 4 * hh - L.qi);
            const f32x2 r2 = (f32x2){rel0, rel0}, m2 = (f32x2){rel0 - L.mid, rel0 - L.mid}, ns2 = (f32x2){-L.slope2, -L.slope2};
#pragma unroll
            for (int i = 0; i < 16; i += 2) { const f32x2 c2 = (f32x2){(float)((i & 3) + 8 * (i >> 2)), (float)(((i + 1) & 3) + 8 * ((i + 1) >> 2))};
                const f32x2 rel = r2 + c2, rc = m2 + c2; const f32x2 ar = (f32x2){__builtin_fabsf(rel.x), __builtin_fabsf(rel.y)};
                const f32x2 s2 = ar * ns2 + (f32x2){sa[t][i], sa[t][i + 1]};
                sa[t][i] = (__builtin_fabsf(rc.x) <= L.hwid) ? s2.x : -1e30f; sa[t][i + 1] = (__builtin_fabsf(rc.y) <= L.hwid) ? s2.y : -1e30f; }
            }
        } else {
            const LAS float* bp = rpbl + (d.h * 15 + (krow[t] - L.rq + 7)) * 31 + (L.kc0 + 4 * hh - L.cq + 15);
            float bias[16];
#pragma unroll
            for (int i = 0; i < 16; ++i) bias[i] = bp[(i & 3) + 8 * (i >> 2)];
            const bool rok = (krow[t] >= L.rs) && (krow[t] <= L.rs + 7); const float cm = rok ? (float)(L.cstart - L.kc0 - 4 * hh) + 7.5f : 1e9f;
#pragma unroll
            for (int i = 0; i < 16; ++i) { const float ci = (float)((i & 3) + 8 * (i >> 2)); const float s = sa[t][i] + bias[i]; sa[t][i] = (__builtin_fabsf(ci - cm) <= 7.5f) ? s : -1e30f; }
        }
#pragma unroll
        for (int i = 0; i < 16; ++i) mloc = fmaxf(mloc, sa[t][i]);
    }
    mloc = fmaxf(mloc, __shfl_xor(mloc, 32));
    const float mn = fmaxf(m, mloc), alpha = __builtin_amdgcn_exp2f(m - mn); m = mn;
    float ps = 0.f;
#pragma unroll
    for (int t = 0; t < NT; ++t)
#pragma unroll
        for (int i = 0; i < 16; ++i) { sa[t][i] = __builtin_amdgcn_exp2f(sa[t][i] - mn); ps += sa[t][i]; }
    l = l * alpha + ps;
#pragma unroll
    for (int i = 0; i < 16; ++i) { o0[i] *= alpha; o1[i] *= alpha; }
#pragma unroll
    for (int t = 0; t < NT; ++t) {
        bf16x8 pb[2];
#pragma unroll
        for (int s2 = 0; s2 < 2; ++s2) { u32x4 w; w.x = pg8::cvt_pk_bf16(sa[t][8 * s2 + 0], sa[t][8 * s2 + 1]); w.y = pg8::cvt_pk_bf16(sa[t][8 * s2 + 2], sa[t][8 * s2 + 3]);
            w.z = pg8::cvt_pk_bf16(sa[t][8 * s2 + 4], sa[t][8 * s2 + 5]); w.w = pg8::cvt_pk_bf16(sa[t][8 * s2 + 6], sa[t][8 * s2 + 7]); pb[s2] = __builtin_bit_cast(bf16x8, w); }
        __builtin_amdgcn_sched_barrier(0);
        const LAS unsigned char* vb = lds + VT_OFF + (rowbase[t] + 4 * hh + ((lane & 15) >> 2)) * VP + (16 * (r >> 4) + 4 * (lane & 3)) * 2;
#pragma unroll
        for (int s2 = 0; s2 < 2; ++s2) {
            const s16x4 a00 = vtr(vb + (16 * s2) * VP), a01 = vtr(vb + (16 * s2 + 8) * VP), a10 = vtr(vb + (16 * s2) * VP + 64), a11 = vtr(vb + (16 * s2 + 8) * VP + 64);
            const bf16x8 A0 = (bf16x8){a00[0], a00[1], a00[2], a00[3], a01[0], a01[1], a01[2], a01[3]}, A1 = (bf16x8){a10[0], a10[1], a10[2], a10[3], a11[0], a11[1], a11[2], a11[3]};
            o0 = __builtin_amdgcn_mfma_f32_32x32x16_bf16(A0, pb[s2], o0, 0, 0, 0);
            o1 = __builtin_amdgcn_mfma_f32_32x32x16_bf16(A1, pb[s2], o1, 0, 0, 0); } }
}

template <int MODE>
__device__ __forceinline__ void attn_compute(const PassDesc& d, LAS unsigned char* lds, const LAS float* rpbl, float& m, float& l, f32x16& o0, f32x16& o1, int wave, int lane) {
    AttnLane L; L.r = lane & 31; L.hh = lane >> 5;
    L.n = SEQ >> d.ls; L.qi = d.i0 + 32 * wave + L.r;
    L.slope2 = exp2f(-8.0f * (float)(d.h + 1) / 6.0f) * LOG2E * (float)(1 << d.ls);
    { const float lo = fmaxf(-64.0f, (float)(-L.qi)), hi = fminf(64.0f, (float)(L.n - 1 - L.qi)); L.mid = 0.5f * (lo + hi); L.hwid = 0.5f * (hi - lo); }
    const int pair = wave >> 2, g = wave & 3; L.rq = d.r0 + 2 * pair + (L.r >> 4); L.cq = 16 * g + (L.r & 15);
    { int cs = L.cq - 8; L.cstart = cs < 0 ? 0 : (cs > 48 ? 48 : cs); }
    L.rs = rstart_of(L.rq); L.kc0 = (g == 0) ? 0 : (g == 1 ? 8 : (g == 2 ? 24 : 32));
    const int wlo = rstart_of(d.r0 + 2 * pair), whi = rstart_of(d.r0 + 2 * pair + 1) + 7;
    constexpr int NST = (MODE == 0) ? 5 : 6;
    int s_lo = NST, s_hi = 0;
#pragma unroll
    for (int st = 0; st < NST; ++st) { bool act;
        if (MODE == 0) { const int jb_ = d.i0 - 64 + 32 * (wave + st); act = !(jb_ + 31 < 0 || jb_ >= L.n); }
        else { const int kr_ = D_KRLO(d) + 6 * d.sub + st; act = !(kr_ > D_KRHI(d) || kr_ < wlo || kr_ > whi); }
        if (act) { s_lo = st < s_lo ? st : s_lo; s_hi = st + 1; } }
#pragma unroll 1
    for (int st = s_lo; st < s_hi; st += 2) {
        if (st + 1 < s_hi) attn_step<MODE, 2>(d, L, lds, rpbl, m, l, o0, o1, wave, lane, st);
        else attn_step<MODE, 1>(d, L, lds, rpbl, m, l, o0, o1, wave, lane, st);
    }
}
__device__ __forceinline__ void attn_final(const Args& a, const PassDesc& d, float m, float l, const f32x16& o0, const f32x16& o1, int wave, int lane) {
    const int hh = lane >> 5, tq = pass_qtok(d, wave, lane);
    const float lt = l + __shfl_xor(l, 32), inv = 1.0f / lt;
    const int slot = d.mode == 0 ? (d.ls >> 1) : 3;
    bf16_t* op = (bf16_t*)(a.ws + WS_OBR + (size_t)slot * OBR_STRIDE) + ((size_t)d.b * SEQ + tq) * 384 + d.h * 64 + 4 * hh;
#pragma unroll
    for (int g4 = 0; g4 < 4; ++g4) {
        u32x2 w0, w1; w0.x = pk2(o0[4 * g4] * inv, o0[4 * g4 + 1] * inv); w0.y = pk2(o0[4 * g4 + 2] * inv, o0[4 * g4 + 3] * inv);
        w1.x = pk2(o1[4 * g4] * inv, o1[4 * g4 + 1] * inv); w1.y = pk2(o1[4 * g4 + 2] * inv, o1[4 * g4 + 3] * inv);
        *(u32x2*)(op + 8 * g4) = w0; *(u32x2*)(op + 32 + 8 * g4) = w1; }
    if (d.mode == 0 && hh == 0) ((float*)(a.ws + WS_LSE))[((size_t)(d.ls >> 1) * MTOK + (size_t)d.b * SEQ + tq) * 6 + d.h] = (m + __log2f(lt)) * LN2;
}

__device__ __forceinline__ void phase_mix(const Args& a, int l, LAS unsigned char* lds, int tid, int lane, int wave, int vb) {
    pool_phase(a, l, lds, tid, vb);
    LAS float* rpbl = (LAS float*)(lds + RPB_OFF);
    for (int i = tid; i < 6 * 15 * 31; i += NTHR) rpbl[i] = a.rpb[(size_t)l * 2790 + i] * LOG2E;
    const bf16_t* Z = (const bf16_t*)(a.ws + WS_Z);
    const int G = gridDim.x, bx = vb;
    const int nA = (G == 256) ? 9 : (bx < NA_UNITS ? (NA_UNITS - bx + G - 1) / G : 0), nC = (G == 256) ? 3 : (bx < NC_UNITS ? (NC_UNITS - bx + G - 1) / G : 0), npass = nA + 2 * nC;
    PassDesc cur, nxt; u32x4 kr[6], vr[6]; bf16x8 qc[4];
    float m = -1e30f, lsum = 0.f; f32x16 o0, o1;
#pragma unroll
    for (int i = 0; i < 16; ++i) { o0[i] = 0.f; o1[i] = 0.f; }
    get_pass(0, nA, cur, vb); nxt = cur;
    if (npass > 0) { attn_load_kv(cur, Z, tid, kr, vr); attn_load_q(cur, Z, wave, lane, qc); }
#pragma unroll 1
    for (int s = 0; s < npass; ++s) {
        LDS_BARRIER();
        attn_stage(lds, tid, kr, vr, qc);
        if (cur.mode == 0 && tid < 191) { const float sl = exp2f(-8.0f * (float)(cur.h + 1) / 6.0f) * LOG2E * (float)(1 << cur.ls); const int ar = tid < 95 ? 95 - tid : tid - 95;
            ((LAS float*)(lds + BT_OFF))[tid] = ar <= 64 ? -sl * (float)ar : -1e30f; }
        LDS_BARRIER();
        if (s + 1 < npass) { get_pass(s + 1, nA, nxt, vb); attn_load_kv(nxt, Z, tid, kr, vr); attn_load_q(nxt, Z, wave, lane, qc); }
        if (cur.mode == 0 || cur.sub == 0) { m = -1e30f; lsum = 0.f;
#pragma unroll
            for (int i = 0; i < 16; ++i) { o0[i] = 0.f; o1[i] = 0.f; } }
        if (cur.mode == 0) attn_compute<0>(cur, lds, rpbl, m, lsum, o0, o1, wave, lane);
        else attn_compute<1>(cur, lds, rpbl, m, lsum, o0, o1, wave, lane);
        if (cur.mode == 0 || cur.sub == 1) attn_final(a, cur, m, lsum, o0, o1, wave, lane);
        cur = nxt;
    }
    __syncthreads();
}

__device__ __forceinline__ void phase_combine(const Args& a, int l, int lane, int gw, int NGW) {
    const bf16_t* __restrict__ OB = (const bf16_t*)(a.ws + WS_OBR); const float* __restrict__ LSE = (const float*)(a.ws + WS_LSE); bf16_t* __restrict__ MIX = (bf16_t*)(a.ws + WS_Z) + MIX_OFF_E;
    constexpr size_t OS = OBR_STRIDE / 2; constexpr int NT = 4;
    const bool act = lane < 48; const int ch = act ? 8 * lane : 0, hd = ch >> 6;
    float ga[8], gc[8];
    { const f32x4 a0 = *(const f32x4*)(a.norm_a_out + l * 384 + ch), a1 = *(const f32x4*)(a.norm_a_out + l * 384 + ch + 4), c0 = *(const f32x4*)(a.norm_c_out + l * 384 + ch), c1 = *(const f32x4*)(a.norm_c_out + l * 384 + ch + 4);
#pragma unroll
      for (int e = 0; e < 4; ++e) { ga[e] = a0[e]; ga[4 + e] = a1[e]; gc[e] = c0[e]; gc[4 + e] = c1[e]; } }
    for (int cj = 0; 16 * (gw + NGW * (cj >> 2)) < MTOK; ++cj) {
        const int tok0 = 16 * (gw + NGW * (cj >> 2)) + NT * (cj & 3);
        u32x4 w[NT][4]; float ls[NT][3];
#pragma unroll
        for (int t = 0; t < NT; ++t) { const size_t tok = tok0 + t;
#pragma unroll
            for (int br = 0; br < 4; ++br) w[t][br] = *(const u32x4*)(OB + br * OS + tok * 384 + ch);
#pragma unroll
            for (int br = 0; br < 3; ++br) ls[t][br] = LSE[((size_t)br * MTOK + tok) * 6 + hd]; }
#pragma unroll
        for (int t = 0; t < NT; ++t) { const size_t tok = tok0 + t;
            const float l0 = ls[t][0], l1 = ls[t][1], l2 = ls[t][2];
            const float mx = fmaxf(l0, fmaxf(l1, l2)), e0 = __expf(l0 - mx), e1 = __expf(l1 - mx), e2 = __expf(l2 - mx), inv = 1.0f / (e0 + e1 + e2);
            float va[8], vc[8]; float ssa = 0.f, ssc = 0.f;
#pragma unroll
            for (int e = 0; e < 4; ++e) { const unsigned w0 = w[t][0][e], w1 = w[t][1][e], w2 = w[t][2][e], w3 = w[t][3][e];
                va[2 * e] = (e0 * bf_lo(w0) + e1 * bf_lo(w1) + e2 * bf_lo(w2)) * inv; va[2 * e + 1] = (e0 * bf_hi(w0) + e1 * bf_hi(w1) + e2 * bf_hi(w2)) * inv;
                vc[2 * e] = bf_lo(w3); vc[2 * e + 1] = bf_hi(w3);
                ssa += va[2 * e] * va[2 * e] + va[2 * e + 1] * va[2 * e + 1]; ssc += vc[2 * e] * vc[2 * e] + vc[2 * e + 1] * vc[2 * e + 1]; }
            if (!act) { ssa = 0.f; ssc = 0.f; }
            const float ra = 1.0f / sqrtf(wave_sum(ssa) * (1.0f / 384.0f) + EPS), rc = 1.0f / sqrtf(wave_sum(ssc) * (1.0f / 384.0f) + EPS);
            if (act) { u32x4 oa, oc;
#pragma unroll
                for (int e = 0; e < 4; ++e) { oa[e] = pk2(va[2 * e] * ra * ga[2 * e], va[2 * e + 1] * ra * ga[2 * e + 1]); oc[e] = pk2(vc[2 * e] * rc * gc[2 * e], vc[2 * e + 1] * rc * gc[2 * e + 1]); }
                bf16_t* mp = MIX + (tok >> 12) * BLK_E + (tok & 4095) * DM + ch; *(u32x4*)mp = oa; *(u32x4*)(mp + 640) = oc; } }
    }
}

#define XB_TMO      128
#define XB_XCNT(j)  (256  + 64 * (j))
#define XB_XSUB(j)  (1280 + 64 * (j))
#define XB_XGEN(j)  (2304 + 64 * (j))
#define XB_TOP      3328
#define XB_TOPGEN   3392
#define XCD_BAR_WORDS 3456
#define XB_SPIN_CAP (1u << 18)

__device__ __forceinline__ unsigned xb_ld(unsigned* p)              { return __hip_atomic_load(p, __ATOMIC_RELAXED, __HIP_MEMORY_SCOPE_AGENT); }
__device__ __forceinline__ unsigned xb_add(unsigned* p, unsigned v) { return __hip_atomic_fetch_add(p, v, __ATOMIC_RELAXED, __HIP_MEMORY_SCOPE_AGENT); }
__device__ __forceinline__ unsigned xb_xcc_id() { return (unsigned)__builtin_amdgcn_s_getreg((3 << 11) | 20) & 0xFu; }
#define XB_SPIN(cond, bar) do { unsigned _sp = 0; while (cond) { __builtin_amdgcn_s_sleep(1); \
    if ((++_sp & 255u) == 0u) { if (xb_ld(&(bar)[XB_TMO])) break; if (_sp > XB_SPIN_CAP) { atomicAdd(&(bar)[XB_TMO], 1u); break; } } } } while (0)

struct XcdBarrier {
    unsigned* bar; unsigned x;
    volatile LAS unsigned* st;
};

__device__ __forceinline__ XcdBarrier xcd_barrier_post(unsigned* bar, volatile LAS unsigned* st) {
    XcdBarrier b; b.bar = bar; b.x = xb_xcc_id(); b.st = st;
    if (threadIdx.x == 0) st[2] = xb_add(&bar[XB_XCNT(b.x)], 1u);
    return b;
}
__device__ __forceinline__ void xcd_barrier_complete(unsigned* bar, unsigned x, unsigned& nloc, unsigned& nx, unsigned& reg) {
    const unsigned G = gridDim.x * gridDim.y * gridDim.z;
    unsigned sum, cnt, mine, sp = 0u;
    for (;;) {
        sum = 0u; cnt = 0u; mine = 0u;
#pragma unroll
        for (unsigned j = 0; j < 16; ++j) { const unsigned c = xb_ld(&bar[XB_XCNT(j)]); sum += c; cnt += (c > 0u) ? 1u : 0u; mine = (j == x) ? c : mine; }
        if (sum == G) break;
        __builtin_amdgcn_s_sleep(1);
        if ((++sp & 255u) == 0u) { if (xb_ld(&bar[XB_TMO])) break; if (sp > XB_SPIN_CAP) { atomicAdd(&bar[XB_TMO], 1u); break; } }
    }
    nloc = mine > 0u ? mine : 1u; nx = cnt > 0u ? cnt : 1u;
    { unsigned ok = (sum == G && G == 256u && x < 8u) ? 1u : 0u;
#pragma unroll
      for (unsigned j = 0; j < 16; ++j) { const unsigned c = xb_ld(&bar[XB_XCNT(j)]); if (c != (j < 8u ? 32u : 0u)) ok = 0u; }
      reg = ok; }
}

__device__ __forceinline__ void xcd_barrier(const XcdBarrier& b) {
    asm volatile("s_waitcnt vmcnt(0)" ::: "memory");
    __syncthreads();
    if (threadIdx.x == 0) {
        unsigned* bar = b.bar;
        __builtin_amdgcn_s_waitcnt(0);
        unsigned nloc = b.st[0], nx = b.st[1];
        if (nloc == 0u) { unsigned reg = 0u; xcd_barrier_complete(bar, b.x, nloc, nx, reg); b.st[0] = nloc; b.st[1] = nx; b.st[3] = reg; }
        const unsigned old = xb_add(&bar[XB_XSUB(b.x)], 1u);
        const unsigned gen = old / nloc;
        if (old + 1u == (gen + 1u) * nloc) {
            __builtin_amdgcn_fence(__ATOMIC_RELEASE, "agent");
            asm volatile("s_waitcnt vmcnt(0)" ::: "memory");
            const unsigned og = xb_add(&bar[XB_TOP], 1u);
            const unsigned tg = og / nx;
            if (og + 1u == (tg + 1u) * nx) xb_add(&bar[XB_TOPGEN], 1u);
            else XB_SPIN(xb_ld(&bar[XB_TOPGEN]) == tg, bar);
            __builtin_amdgcn_fence(__ATOMIC_ACQUIRE, "agent");
            xb_add(&bar[XB_XGEN(b.x)], 1u);
            asm volatile("s_waitcnt vmcnt(0)" ::: "memory");
        } else {
            XB_SPIN(xb_ld(&bar[XB_XGEN(b.x)]) == gen, bar);
            __builtin_amdgcn_fence(__ATOMIC_ACQUIRE, "agent");
            asm volatile("s_waitcnt vmcnt(0)" ::: "memory");
        }
    }
    __syncthreads();
}

__device__ __forceinline__ void xcd_barrier_local(const XcdBarrier& b) {
    asm volatile("s_waitcnt vmcnt(0)" ::: "memory");
    __syncthreads();
    if (threadIdx.x == 0) {
        unsigned* bar = b.bar;
        __builtin_amdgcn_s_waitcnt(0);
        const unsigned nloc = b.st[0];
        const unsigned old = xb_add(&bar[XB_XSUB(b.x)], 1u);
        const unsigned gen = old / nloc;
        if (old + 1u == (gen + 1u) * nloc) xb_add(&bar[XB_XGEN(b.x)], 1u);
        else XB_SPIN(xb_ld(&bar[XB_XGEN(b.x)]) == gen, bar);
        __builtin_amdgcn_fence(__ATOMIC_ACQUIRE, "agent");
        asm volatile("s_waitcnt vmcnt(0)" ::: "memory");
    }
    __syncthreads();
}
#ifndef PH_MASK
#define PH_MASK 0x3ff
#endif
#ifndef REP_MASK
#define REP_MASK 0
#endif
constexpr unsigned REPM = REP_MASK;
constexpr unsigned PHM = PH_MASK;
constexpr int N_PHASES = 18;
__global__ void __launch_bounds__(NTHR, 2) fwd_mega(Args a) {
    extern __shared__ __attribute__((aligned(16))) unsigned char lds_raw[];
    LAS unsigned char* lds = (LAS unsigned char*)lds_raw;
    const int n_it = (a.ph_hi - a.ph_lo) * (REPM ? 2 : 1);
    volatile LAS unsigned* xst = (volatile LAS unsigned*)(lds + LDS_XB_OFF);
    if (threadIdx.x < 4) xst[threadIdx.x] = 0u;
    __syncthreads();
    if (a.ph_lo < 0) cg::this_grid().sync();
    const XcdBarrier xbar = xcd_barrier_post((unsigned*)(a.ws + WS_BAR), xst);
    for (int it = 0; it < n_it; ++it) {
        const int ph = a.ph_lo + (REPM ? (it >> 1) : it);
        if (REPM && (it & 1) && !((ph >= 1 && ph < N_PHASES - 1 && ((REPM >> ((ph - 1) & 7)) & 1u)) || (ph == 0 && (REPM & 0x100u)))) continue;
        const bool dummy = REPM && (it & 1);
        if (it == 1) xcd_barrier(xbar);
        const bool regular = it >= 1 && __builtin_amdgcn_readfirstlane((int)xst[3]) != 0;
        if (it > 1) { if (regular) xcd_barrier_local(xbar); else xcd_barrier(xbar); }
        const int vb = regular ? __builtin_amdgcn_readfirstlane((int)(xst[2] * 8u + xbar.x)) : (int)blockIdx.x;
        int tid = threadIdx.x; asm volatile("" : "+v"(tid));
        const int lane = tid & 63, wave = __builtin_amdgcn_readfirstlane(tid >> 6);
        const int NGW = gridDim.x * NWAVES, gw = (gridDim.x == 256) ? 256 * (vb & 7) + 8 * (vb >> 3) + wave : vb * NWAVES + wave;
        if (ph == 0) { if (PHM & 1) phase_p0(a, lds, tid, lane, wave); continue; }
        if (ph == N_PHASES - 1) { if (PHM & 2) norm_rows_bf<true>((const bf16_t*)(a.ws + WS_X), a.norm_final, nullptr, nullptr, nullptr, a.out, gw, NGW, lane); continue; }
        const int l = (ph - 1) >> 3, k = (ph - 1) & 7;
        const float* modl = (const float*)(a.ws + WS_MOD) + (size_t)l * NB * 6144;
        bf16_t* H = (bf16_t*)(a.ws + WS_H); bf16_t* Z = (bf16_t*)(a.ws + WS_Z); bf16_t* MIX = (bf16_t*)(a.ws + WS_Z) + MIX_OFF_E; bf16_t* ACT = (bf16_t*)(a.ws + WS_Z);
        const unsigned char* wl = a.ws + WS_W + (size_t)l * W_LAYER;
        bf16_t* XS = (bf16_t*)(a.ws + WS_X);
        if (k == 0) { if (PHM & 4) { if (l == 0) norm_rows<false>(a.x, a.norm_mix + l * DM, modl + 1024, modl, H, nullptr, gw, NGW, lane);
                                         else norm_rows_bf<false>(XS, a.norm_mix + l * DM, modl + 1024, modl, H, nullptr, gw, NGW, lane); } }
        else if (k == 1) { if (PHM & 8) { pg8::Gemm g{H, (const bf16_t*)(wl + W_IN), MTOK, PW, DM, 0}; pg8::StaticOrder S; S.init(MTOK, PW, gridDim.x, vb);
            pg8::EpiZH E{Z}; pg8::gemm_phase<pg8::EpiZH, pg8::StaticOrder, true, true>(lds, g, S, E, tid); } }
        else if (k == 2) { if (PHM & 16) phase_mix(a, l, lds, tid, lane, wave, vb); }
        else if (k == 3) { if (PHM & 32) phase_combine(a, l, lane, gw, NGW); }
        else if (k == 4) { if (PHM & 64) { pg8::Gemm g{MIX, (const bf16_t*)(wl + W_OUT), MTOK, DM, DM, MIX_GAP_E}; pg8::StaticOrder S; S.init(MTOK, DM, gridDim.x, vb);
            if (l == 0) { pg8::EpiResid<true> E{a.x, dummy ? (bf16_t*)(a.ws + 337 * MiB) : XS, modl + 2048}; pg8::gemm_phase<pg8::EpiResid<true>, pg8::StaticOrder, true, true>(lds, g, S, E, tid); }
            else { pg8::EpiResid<false> E{XS, XS, modl + 2048}; pg8::gemm_phase<pg8::EpiResid<false>, pg8::StaticOrder, true, true>(lds, g, S, E, tid); } } }
        else if (k == 5) { if (PHM & 128) norm_rows_bf<false>(XS, a.norm_ffn + l * DM, modl + 4096, modl + 3072, H, nullptr, gw, NGW, lane); }
        else if (k == 6) { if (PHM & 256) { pg8::Gemm g{H, (const bf16_t*)(wl + W_FI), MTOK, 2 * FF, DM, 0}; pg8::StaticOrder S; S.init(MTOK, 2 * FF, gridDim.x, vb);
            pg8::EpiSwiGLU E{ACT, FF, ACT_GAP_E}; pg8::gemm_phase<pg8::EpiSwiGLU, pg8::StaticOrder, true, true>(lds, g, S, E, tid); } }
        else { if (PHM & 512) { pg8::Gemm g{ACT, (const bf16_t*)(wl + W_FO), MTOK, DM, FF, ACT_GAP_E}; pg8::StaticOrder S; S.init(MTOK, DM, gridDim.x, vb);
            pg8::EpiResid<false> E{XS, dummy ? (bf16_t*)(a.ws + 337 * MiB) : XS, modl + 5120}; pg8::gemm_phase<pg8::EpiResid<false>, pg8::StaticOrder, true, true>(lds, g, S, E, tid); } }
    }
}

extern "C" void kernel_launch(void* const* d_in, const int* in_sizes, int n_in, void* d_out, int out_size, void* d_ws, size_t ws_size, hipStream_t stream) {
    static int grid = 0;
    if (grid == 0) {
        if (n_in != 16 || out_size != MTOK * DM || ws_size < WS_END) { fprintf(stderr, "kernel_launch: unexpected shapes (n_in %d out %d ws %zu)\n", n_in, out_size, ws_size); grid = -1; return; }
        int dev = 0, cus = 0, per_cu = 0;
        hipGetDevice(&dev); hipDeviceGetAttribute(&cus, hipDeviceAttributeMultiprocessorCount, dev);
        if (hipFuncSetAttribute((const void*)fwd_mega, hipFuncAttributeMaxDynamicSharedMemorySize, LDS_BYTES) != hipSuccess) { fprintf(stderr, "kernel_launch: hipFuncSetAttribute failed\n"); grid = -1; return; }
        if (hipOccupancyMaxActiveBlocksPerMultiprocessor(&per_cu, (const void*)fwd_mega, NTHR, LDS_BYTES) != hipSuccess || per_cu < 1) { fprintf(stderr, "kernel_launch: occupancy query says %d\n", per_cu); per_cu = 1; }
        (void)hipGetLastError();
        grid = cus * (per_cu > 1 ? 1 : per_cu);
    }
    if (grid < 0) return;
    if (hipMemsetAsync((char*)d_ws + WS_BAR, 0, 16384, stream) != hipSuccess) { fprintf(stderr, "kernel_launch: memset of the barrier words failed\n"); return; }
    Args a{};
    a.x = (const float*)d_in[0]; a.c = (const float*)d_in[1]; a.w_ada = (const float*)d_in[2]; a.b_ada = (const float*)d_in[3]; a.norm_mix = (const float*)d_in[4];
    a.w_in = (const float*)d_in[5]; a.norm_a_out = (const float*)d_in[6]; a.norm_c_out = (const float*)d_in[7]; a.w_pool = (const float*)d_in[8]; a.pool_scale = (const float*)d_in[9];
    a.rpb = (const float*)d_in[10]; a.w_out = (const float*)d_in[11]; a.norm_ffn = (const float*)d_in[12]; a.w_ffn_in = (const float*)d_in[13]; a.w_ffn_out = (const float*)d_in[14];
    a.norm_final = (const float*)d_in[15]; a.out = (float*)d_out; a.ws = (unsigned char*)d_ws;
#if MK_PER_PHASE
    for (int ph = 0; ph < N_PHASES; ++ph) { a.ph_lo = ph; a.ph_hi = ph + 1; void* args[] = {&a};
        hipError_t e = hipLaunchCooperativeKernel((const void*)fwd_mega, dim3(grid), dim3(NTHR), args, LDS_BYTES, stream);
        if (e != hipSuccess) { fprintf(stderr, "launch %d failed: %s\n", ph, hipGetErrorString(e)); break; } }
#else
    a.ph_lo = 0; a.ph_hi = N_PHASES; void* args[] = {&a};
    hipError_t e = hipLaunchCooperativeKernel((const void*)fwd_mega, dim3(grid), dim3(NTHR), args, LDS_BYTES, stream);
    if (e != hipSuccess) fprintf(stderr, "cooperative launch failed: %s (grid %d)\n", hipGetErrorString(e), grid);
#endif
}
```

```cpp
#include <hip/hip_runtime.h>
#include <hip/hip_cooperative_groups.h>
#include <cstdio>
#include <cstdint>
namespace cg = cooperative_groups;
#ifndef MK_PER_PHASE
#define MK_PER_PHASE 0
#endif
namespace pg8 {
#define PG8_LAS __attribute__((address_space(3)))
typedef unsigned short bf16_t;
typedef short bf16x8 __attribute__((ext_vector_type(8)));
typedef float f32x4 __attribute__((ext_vector_type(4)));
typedef unsigned u32x4 __attribute__((ext_vector_type(4)));
constexpr int BM = 256, BK = 64, HALF = 128, HTB = HALF * BK * 2  , STAGE_BYTES = 8 * HTB, NXCD = 8, WGM = 8;

__host__ __device__ __forceinline__ int lds_byte(int r, int c) { const int st = (r >> 4) * 2 + (c >> 5), rr = r & 15, cc = c & 31, ob = rr * 64 + cc * 2; return st * 1024 + (ob ^ (((ob >> 9) & 1) << 5)); }
__host__ __device__ __forceinline__ void stage_rc(int b, int& R, int& C) { const int st = b / 1024, sb = b % 1024, swz = sb ^ (((sb >> 9) & 1) << 5); R = (st >> 1) * 16 + swz / 64; C = (st & 1) * 32 + (swz % 64) / 2; }
__host__ __device__ __forceinline__ int perm32(int rho) { const int n = rho >> 4, i = rho & 15; return 8 * (i >> 2) + 4 * n + (i & 3); }

struct Unit { int pm, pn; };
struct Gemm { const bf16_t* A; const bf16_t* Bt; int M, N, K; size_t agap; };

struct StaticOrder {
    int nM, nN, nwg, G, c;
    __host__ __device__ void init(int M, int N, int G_, int c_) { nM = M / BM; nN = N / BM; nwg = nM * nN; G = G_; c = c_; }
    __host__ __device__ bool next(int i, Unit& u) const {
        const long L = (long)i * G + c; if (L >= nwg) return false;
        int wgid = (int)L; { const int q = nwg / NXCD, r = nwg % NXCD, xcd = wgid % NXCD, off = wgid / NXCD; wgid = (xcd < r ? xcd * (q + 1) : r * (q + 1) + (xcd - r) * q) + off; }
        const int nig = WGM * nN, gid = wgid / nig, fm = gid * WGM, gsz = (nM - fm) < WGM ? (nM - fm) : WGM;
        u.pm = fm + ((wgid % nig) % gsz); u.pn = (wgid % nig) / gsz; return true;
    }
    __device__ __forceinline__ void a_ready(const Unit&) const {}
    __device__ __forceinline__ void done(const Unit&) const {}
};

__device__ __forceinline__ unsigned cvt_pk_bf16(float lo, float hi) { unsigned r; asm volatile("v_cvt_pk_bf16_f32 %0, %1, %2" : "=v"(r) : "v"(lo), "v"(hi)); return r; }
typedef float f32x2 __attribute__((ext_vector_type(2)));
typedef unsigned u32x2 __attribute__((ext_vector_type(2)));
__device__ __forceinline__ float silu_f(float g) { return g * __builtin_amdgcn_rcpf(1.0f + __builtin_amdgcn_exp2f(-1.4426950408889634f * g)); }
struct EpiZH { static constexpr bool KSCALE = false;
    static constexpr bool PERM = true, AFTER_DRAIN = false;
    static constexpr size_t SEG = (size_t)6 * 4096 * 64, BLK = (size_t)14 << 20;
    bf16_t* Zh;
    __device__ __forceinline__ void operator()(const f32x4 (&acc)[2][2][4][2], const Unit& u, int wr, int wc, int fr, int fq) const {
        const int m0 = u.pm * BM, b = m0 >> 12, t0 = (m0 & 4095) + wr * 64 + fr;
#pragma unroll
        for (int bj = 0; bj < 2; ++bj) {
            const int colw = u.pn * BM + bj * HALF + wc * 32;
            bf16_t* dst; int ld; float qs = 1.0f;
            if (colw >= 1152 && colw < 1408) { dst = Zh + (size_t)b * BLK + 6 * SEG + (colw - 1152) + 8 * fq; ld = 256; }
            else { const int cc = colw < 1152 ? colw : colw - 1408, seg = (colw < 1152 ? 0 : 3) + cc / 384, rem = cc % 384, h = rem >> 6, d0 = rem & 63;
                   dst = Zh + (size_t)b * BLK + (size_t)seg * SEG + (size_t)h * 4096 * 64 + d0 + 8 * fq; ld = 64; qs = (seg == 0 || seg == 3) ? 0.125f * 1.4426950408889634f : 1.0f; }
#pragma unroll
            for (int ai = 0; ai < 2; ++ai)
#pragma unroll
                for (int m = 0; m < 4; ++m) { const f32x4 v0 = acc[ai][bj][m][0] * qs, v1 = acc[ai][bj][m][1] * qs;
                    u32x4 w; w.x = cvt_pk_bf16(v0[0], v0[1]); w.y = cvt_pk_bf16(v0[2], v0[3]); w.z = cvt_pk_bf16(v1[0], v1[1]); w.w = cvt_pk_bf16(v1[2], v1[3]);
                    *(u32x4*)(dst + (size_t)(t0 + ai * HALF + m * 16) * ld) = w; } }
    }
};
struct EpiSwiGLU { static constexpr bool KSCALE = false;
    static constexpr bool PERM = true, AFTER_DRAIN = false;
    bf16_t* O; int ldc; size_t ogap;
    __device__ __forceinline__ void operator()(const f32x4 (&acc)[2][2][4][2], const Unit& u, int wr, int wc, int fr, int fq) const {
        const int row0 = u.pm * BM + wr * 64 + fr, col0 = u.pn * HALF + wc * 32 + 8 * fq;
#pragma unroll
        for (int ai = 0; ai < 2; ++ai)
#pragma unroll
            for (int m = 0; m < 4; ++m) { bf16_t* rowp = O + (size_t)(row0 + ai * HALF + m * 16) * ldc + (size_t)(u.pm >> 4) * ogap + col0;
                const f32x4 g0 = acc[ai][0][m][0], g1 = acc[ai][0][m][1], u0 = acc[ai][1][m][0], u1 = acc[ai][1][m][1];
                u32x4 w; w.x = cvt_pk_bf16(silu_f(g0[0]) * u0[0], silu_f(g0[1]) * u0[1]); w.y = cvt_pk_bf16(silu_f(g0[2]) * u0[2], silu_f(g0[3]) * u0[3]);
                w.z = cvt_pk_bf16(silu_f(g1[0]) * u1[0], silu_f(g1[1]) * u1[1]); w.w = cvt_pk_bf16(silu_f(g1[2]) * u1[2], silu_f(g1[3]) * u1[3]);
                *(u32x4*)rowp = w; }
    }
};
template <bool BASE_F32, bool KSC = false>
struct EpiResid {
    static constexpr bool PERM = true, AFTER_DRAIN = false, KSCALE = KSC;
    const void* base; bf16_t* out; const float* gate; const float* ssc;
    __device__ __forceinline__ void kscale(f32x4 (&acc)[2][2][4][2], const Unit& u, int wr, int fr) const {
        const int fr_ = (int)(__builtin_amdgcn_mbcnt_hi(~0u, __builtin_amdgcn_mbcnt_lo(~0u, 0u)) & 15u);
        (void)fr;
        const unsigned off0 = (unsigned)(u.pm * BM + wr * 64 + fr_) * 24u;
#pragma unroll
        for (int ai = 0; ai < 2; ++ai)
#pragma unroll
            for (int m = 0; m < 4; ++m) { const char* sp = (const char*)ssc + (off0 + (unsigned)((ai * HALF + m * 16) * 24));
                const f32x2 s0 = *(const f32x2*)sp, s1 = *(const f32x2*)(sp + 8), s2 = *(const f32x2*)(sp + 16);
                const float f = __builtin_amdgcn_rsqf(((s0.x + s0.y) + (s1.x + s1.y) + (s2.x + s2.y)) * (1.0f / 384.0f) + 1e-6f);
#pragma unroll
                for (int bj = 0; bj < 2; ++bj)
#pragma unroll
                    for (int n = 0; n < 2; ++n) acc[ai][bj][m][n] *= f;
                __builtin_amdgcn_sched_barrier(0); }
    }
    __device__ __forceinline__ void operator()(const f32x4 (&acc)[2][2][4][2], const Unit& u, int wr, int wc, int fr, int fq) const {
        const int row0 = u.pm * BM + wr * 64 + fr, col0 = u.pn * BM + wc * 32 + 8 * fq;
        const float* gp = gate + (size_t)(u.pm >> 4) * 6144 + col0;
        f32x4 gv[2][2];
#pragma unroll
        for (int bj = 0; bj < 2; ++bj)
#pragma unroll
            for (int n = 0; n < 2; ++n) gv[bj][n] = *(const f32x4*)(gp + bj * HALF + n * 4);
        constexpr int MB = BASE_F32 ? 1 : 4;
#pragma unroll
        for (int ai = 0; ai < 2; ++ai)
#pragma unroll
            for (int mb = 0; mb < 4; mb += MB) {
                f32x4 bl[MB][2][2]; u32x4 bw[MB][2];
#pragma unroll
                for (int mi = 0; mi < MB; ++mi) { const size_t off = (size_t)(row0 + ai * HALF + (mb + mi) * 16) * 1024 + col0;
#pragma unroll
                    for (int bj = 0; bj < 2; ++bj) {
                        if (BASE_F32) { bl[mi][bj][0] = *(const f32x4*)((const float*)base + off + bj * HALF); bl[mi][bj][1] = *(const f32x4*)((const float*)base + off + bj * HALF + 4); }
                        else bw[mi][bj] = *(const u32x4*)((const bf16_t*)base + off + bj * HALF); } }
#pragma unroll
                for (int mi = 0; mi < MB; ++mi) { const int m = mb + mi; const size_t off = (size_t)(row0 + ai * HALF + m * 16) * 1024 + col0;
#pragma unroll
                    for (int bj = 0; bj < 2; ++bj) { f32x4 b0, b1;
                        if (BASE_F32) { b0 = bl[mi][bj][0]; b1 = bl[mi][bj][1]; }
                        else { const u32x4 w = bw[mi][bj];
                               b0 = (f32x4){__builtin_bit_cast(float, w.x << 16), __builtin_bit_cast(float, w.x & 0xffff0000u), __builtin_bit_cast(float, w.y << 16), __builtin_bit_cast(float, w.y & 0xffff0000u)};
                               b1 = (f32x4){__builtin_bit_cast(float, w.z << 16), __builtin_bit_cast(float, w.z & 0xffff0000u), __builtin_bit_cast(float, w.w << 16), __builtin_bit_cast(float, w.w & 0xffff0000u)}; }
                        const f32x4 o0 = b0 + gv[bj][0] * acc[ai][bj][m][0], o1 = b1 + gv[bj][1] * acc[ai][bj][m][1];
                        u32x4 r; r.x = cvt_pk_bf16(o0[0], o0[1]); r.y = cvt_pk_bf16(o0[2], o0[3]); r.z = cvt_pk_bf16(o1[0], o1[1]); r.w = cvt_pk_bf16(o1[2], o1[3]);
                        *(u32x4*)(out + off + bj * HALF) = r; } }
                asm volatile("" ::: "memory"); }
    }
};
template <class Epi, class Sched, bool ALIGN_EPI = false, bool SP2 = false>
__device__ __forceinline__ void gemm_phase(PG8_LAS unsigned char* lds, const Gemm g, const Sched& S, const Epi& E, const int tid) {
    const int wid = __builtin_amdgcn_readfirstlane(tid >> 6), lane = tid & 63, wr = wid >> 2, wc = wid & 3, fr = lane & 15, fq = lane >> 4;
    const int K = g.K, nt = K / BK;
    unsigned voffA[2], voffB[2];
#pragma unroll
    for (int i = 0; i < 2; ++i) { int R, C; stage_rc(tid * 16 + i * 8192, R, C); const int Rb = Epi::PERM ? ((R & ~31) + perm32(R & 31)) : R;
        voffA[i] = (unsigned)(R * K + C) * 2u; voffB[i] = (unsigned)(Rb * K + C) * 2u; }
    const size_t kstep = (size_t)(BK * 2);
    const size_t hstep = (size_t)HALF * K * 2;
    const size_t tstep = 2 * hstep;
    const unsigned ldsw = (unsigned)wid * 1024u;
    const int aoff = lds_byte(wr * 64 + fr, fq * 8), boff = lds_byte(wc * 32 + fr, fq * 8);
#define PG8_SA(b, h) (((b) * 2 + (h)) * HTB)
#define PG8_SB(b, h) ((4 + (b) * 2 + (h)) * HTB)
#define PG8_STAGE(bufoff, gbase, voff) do { _Pragma("unroll") for (int _i = 0; _i < 2; ++_i) \
        __builtin_amdgcn_global_load_lds((const unsigned*)((const char*)(gbase) + (voff)[_i]), (PG8_LAS unsigned*)(lds + (bufoff) + ldsw + _i * 8192), 16, 0, 0); } while (0)
#define PG8_LDA(dst, b, h) do { _Pragma("unroll") for (int m = 0; m < 4; ++m) _Pragma("unroll") for (int k = 0; k < 2; ++k) dst[m][k] = *(const PG8_LAS bf16x8*)(lds + PG8_SA(b, h) + aoff + m * 2048 + k * 1024); } while (0)
#define PG8_LDB(dst, b, h) do { _Pragma("unroll") for (int n = 0; n < 2; ++n) _Pragma("unroll") for (int k = 0; k < 2; ++k) dst[n][k] = *(const PG8_LAS bf16x8*)(lds + PG8_SB(b, h) + boff + n * 2048 + k * 1024); } while (0)
#define PG8_MMA(ai, bj, At, Bt) do { __builtin_amdgcn_s_setprio(1); _Pragma("unroll") for (int m = 0; m < 4; ++m) _Pragma("unroll") for (int n = 0; n < 2; ++n) _Pragma("unroll") for (int k = 0; k < 2; ++k) \
        acc[ai][bj][m][n] = __builtin_amdgcn_mfma_f32_16x16x32_bf16(Bt[n][k], At[m][k], acc[ai][bj][m][n], 0, 0, 0); __builtin_amdgcn_s_setprio(0); } while (0)
#define PG8_WAIT_V(n) asm volatile("s_waitcnt vmcnt(" #n ")" ::: "memory")
#define PG8_WAIT_L(n) asm volatile("s_waitcnt lgkmcnt(" #n ")" ::: "memory")
#define PG8_BAR __builtin_amdgcn_s_barrier()
#define PG8_SCHED __builtin_amdgcn_sched_barrier(0)
    Unit cur, nxt; int ui = 0;
    if (!S.next(0, cur)) return;
    f32x4 acc[2][2][4][2];
#pragma unroll
    for (int a = 0; a < 2; ++a)
#pragma unroll
        for (int b = 0; b < 2; ++b)
#pragma unroll
            for (int m = 0; m < 4; ++m)
#pragma unroll
                for (int n = 0; n < 2; ++n) acc[a][b][m][n] = (f32x4){0.f, 0.f, 0.f, 0.f};
    bf16x8 At[4][2], B0[2][2], B1[2][2];
    const char* cA = (const char*)g.A + (size_t)cur.pm * tstep + (size_t)(cur.pm >> 4) * g.agap * 2; const char* cB = (const char*)g.Bt + (size_t)cur.pn * tstep;
    S.a_ready(cur);
    if constexpr (SP2) {
        PG8_STAGE(PG8_SB(0, 0), cB, voffB); PG8_STAGE(PG8_SB(0, 1), cB + hstep, voffB); PG8_STAGE(PG8_SA(0, 0), cA, voffA); PG8_STAGE(PG8_SA(0, 1), cA + hstep, voffA);
        if (wr == 1) PG8_BAR;
        PG8_WAIT_V(2); PG8_BAR;
        PG8_STAGE(PG8_SB(1, 0), cB + kstep, voffB); PG8_STAGE(PG8_SA(1, 0), cA + kstep, voffA); PG8_STAGE(PG8_SB(1, 1), cB + hstep + kstep, voffB);
        PG8_WAIT_V(6); PG8_BAR;
    } else {
        PG8_STAGE(PG8_SB(0, 0), cB, voffB); PG8_STAGE(PG8_SA(0, 0), cA, voffA); PG8_STAGE(PG8_SB(0, 1), cB + hstep, voffB); PG8_STAGE(PG8_SA(0, 1), cA + hstep, voffA);
        if (wr == 1) PG8_BAR;
        PG8_WAIT_V(4); PG8_BAR;
        PG8_STAGE(PG8_SB(1, 0), cB + kstep, voffB); PG8_STAGE(PG8_SA(1, 0), cA + kstep, voffA); PG8_STAGE(PG8_SB(1, 1), cB + hstep + kstep, voffB);
        PG8_WAIT_V(6); PG8_BAR;
    }
    for (;;) {
        const bool has_next = S.next(ui + 1, nxt);
        const char* nA = has_next ? (const char*)g.A + (size_t)nxt.pm * tstep + (size_t)(nxt.pm >> 4) * g.agap * 2 : cA; const char* nB = has_next ? (const char*)g.Bt + (size_t)nxt.pn * tstep : cB;
        for (int t = 0; t < nt; t += 2) {
            const bool last = (t == nt - 2);
            const char* a1 = cA + (size_t)(t + 1) * kstep;
            const char* a2 = last ? nA : cA + (size_t)(t + 2) * kstep; const char* b2 = last ? nB : cB + (size_t)(t + 2) * kstep;
            const char* a3 = a2 + kstep; const char* b3 = b2 + kstep;
            if (last && has_next) S.a_ready(nxt);
            if constexpr (SP2) {
            PG8_LDB(B0, 0, 0); PG8_LDB(B1, 0, 1); PG8_SCHED; PG8_LDA(At, 0, 0); PG8_STAGE(PG8_SA(1, 1), a1 + hstep, voffA);
            PG8_WAIT_V(8); PG8_WAIT_L(0); PG8_BAR; PG8_MMA(0, 0, At, B0); PG8_MMA(0, 1, At, B1); PG8_BAR; PG8_SCHED;
            PG8_LDA(At, 0, 1); PG8_STAGE(PG8_SB(0, 0), b2, voffB); PG8_STAGE(PG8_SB(0, 1), b2 + hstep, voffB); PG8_STAGE(PG8_SA(0, 0), a2, voffA);
            PG8_WAIT_V(8); PG8_WAIT_L(0); PG8_BAR; PG8_MMA(1, 0, At, B0); PG8_MMA(1, 1, At, B1); PG8_BAR; PG8_SCHED;
            PG8_LDB(B0, 1, 0); PG8_LDB(B1, 1, 1); PG8_SCHED; PG8_LDA(At, 1, 0); PG8_STAGE(PG8_SA(0, 1), a2 + hstep, voffA);
            PG8_WAIT_V(8); PG8_WAIT_L(0); PG8_BAR; PG8_MMA(0, 0, At, B0); PG8_MMA(0, 1, At, B1); PG8_BAR; PG8_SCHED;
            PG8_LDA(At, 1, 1); PG8_STAGE(PG8_SB(1, 0), b3, voffB); PG8_STAGE(PG8_SB(1, 1), b3 + hstep, voffB); PG8_STAGE(PG8_SA(1, 0), a3, voffA);
            PG8_WAIT_V(8); PG8_WAIT_L(0); PG8_BAR; PG8_MMA(1, 0, At, B0); PG8_MMA(1, 1, At, B1); PG8_BAR; PG8_SCHED;
            } else {
            PG8_LDB(B0, 0, 0); PG8_SCHED; PG8_LDA(At, 0, 0); PG8_STAGE(PG8_SA(1, 1), a1 + hstep, voffA);
            PG8_WAIT_L(8); PG8_BAR; PG8_WAIT_L(0); PG8_MMA(0, 0, At, B0); PG8_BAR; PG8_SCHED;
            PG8_LDB(B1, 0, 1); PG8_STAGE(PG8_SB(0, 0), b2, voffB);
            PG8_BAR; PG8_WAIT_L(0); PG8_MMA(0, 1, At, B1); PG8_BAR;
            PG8_LDA(At, 0, 1); PG8_STAGE(PG8_SA(0, 0), a2, voffA);
            PG8_BAR; PG8_WAIT_L(0); PG8_MMA(1, 0, At, B0); PG8_BAR; PG8_SCHED;
            PG8_STAGE(PG8_SB(0, 1), b2 + hstep, voffB);
            PG8_WAIT_V(6); PG8_BAR; PG8_MMA(1, 1, At, B1); PG8_BAR;
            PG8_LDB(B0, 1, 0); PG8_SCHED; PG8_LDA(At, 1, 0); PG8_STAGE(PG8_SA(0, 1), a2 + hstep, voffA);
            PG8_WAIT_L(8); PG8_BAR; PG8_WAIT_L(0); PG8_MMA(0, 0, At, B0); PG8_BAR; PG8_SCHED;
            PG8_LDB(B1, 1, 1); PG8_STAGE(PG8_SB(1, 0), b3, voffB);
            PG8_BAR; PG8_WAIT_L(0); PG8_MMA(0, 1, At, B1); PG8_BAR;
            PG8_LDA(At, 1, 1); PG8_STAGE(PG8_SA(1, 0), a3, voffA);
            PG8_BAR; PG8_WAIT_L(0); PG8_MMA(1, 0, At, B0); PG8_BAR; PG8_SCHED;
            PG8_STAGE(PG8_SB(1, 1), b3 + hstep, voffB);
            PG8_WAIT_V(6); PG8_BAR; PG8_MMA(1, 1, At, B1); PG8_BAR;
            }
            if constexpr (Epi::KSCALE) { if (t == 4) E.kscale(acc, cur, wr, fr); }
        }
        if constexpr (ALIGN_EPI) { if (wr == 0) PG8_BAR; }
        if constexpr (!Epi::AFTER_DRAIN) { E(acc, cur, wr, wc, fr, fq); S.done(cur); }
        if (!has_next) break;
#pragma unroll
        for (int a = 0; a < 2; ++a)
#pragma unroll
            for (int b = 0; b < 2; ++b)
#pragma unroll
                for (int m = 0; m < 4; ++m)
#pragma unroll
                    for (int n = 0; n < 2; ++n) acc[a][b][m][n] = (f32x4){0.f, 0.f, 0.f, 0.f};
        cur = nxt; cA = nA; cB = nB; ++ui;
        if constexpr (ALIGN_EPI) { if (wr == 1) PG8_BAR; }
    }
    PG8_WAIT_V(0);
    if constexpr (!ALIGN_EPI) { if (wr == 0) PG8_BAR; }
    PG8_BAR;
    if constexpr (Epi::AFTER_DRAIN) { E.fused(acc, cur, wr, wc, fr, fq, lds, wid, lane); S.done(cur); }
#undef PG8_SA
#undef PG8_SB
#undef PG8_STAGE
#undef PG8_LDA
#undef PG8_LDB
#undef PG8_MMA
#undef PG8_WAIT_V
#undef PG8_WAIT_L
#undef PG8_BAR
#undef PG8_SCHED
}
}

#define LAS __attribute__((address_space(3)))
typedef unsigned short bf16_t;
typedef short bf16x8 __attribute__((ext_vector_type(8)));
typedef short s16x4 __attribute__((ext_vector_type(4)));
typedef float f32x4 __attribute__((ext_vector_type(4)));
typedef float f32x16 __attribute__((ext_vector_type(16)));
typedef unsigned u32x4 __attribute__((ext_vector_type(4)));
typedef unsigned u32x2 __attribute__((ext_vector_type(2)));

constexpr int NWAVES = 8, NTHR = 512;
constexpr int NB = 8, SEQ = 4096, DM = 1024, MTOK = NB * SEQ, PW = 2560, FF = 2816, NLAYER = 2;
constexpr int LDS_BYTES = 163840;
constexpr int LDS_XB_OFF = 159744;
constexpr float EPS = 1e-6f, LOG2E = 1.4426950408889634f, LN2 = 0.6931471805599453f;
constexpr size_t MiB = 1u << 20;
constexpr size_t WS_MOD = 0;
constexpr size_t WS_BAR = 512 * 1024;
constexpr size_t WS_W = 1 * MiB, W_LAYER = 24 * MiB;
constexpr size_t W_IN = 0, W_OUT = 5 * MiB, W_FI = 7 * MiB, W_FO = 18 * MiB;
constexpr size_t WS_H = 49 * MiB;
constexpr size_t WS_Z = 113 * MiB;
constexpr size_t BLK_E = (size_t)14 * MiB;
constexpr size_t ZSEG = (size_t)6 * 4096 * 64;
constexpr size_t UB_OFF_E = 6 * ZSEG;
constexpr size_t MIX_OFF_E = (size_t)10 * MiB;
constexpr size_t MIX_GAP_E = BLK_E - (size_t)4096 * 1024;
constexpr size_t ACT_GAP_E = BLK_E - (size_t)4096 * 2816;
constexpr size_t WS_OBR = 337 * MiB, OBR_STRIDE = 24 * MiB;
constexpr size_t WS_LSE = 433 * MiB;
constexpr size_t WS_SSC = 435 * MiB + 256 * 1024;
constexpr size_t WS_X = 440 * MiB;
constexpr size_t WS_END = 504 * MiB;
static_assert(WS_Z + 8 * BLK_E * 2 <= WS_OBR && UB_OFF_E + (size_t)4096 * 256 <= MIX_OFF_E && MIX_OFF_E + (size_t)4096 * 1024 <= BLK_E && (size_t)4096 * 2816 <= BLK_E && W_FO + (size_t)DM * FF * 2 <= W_LAYER, "ws map");

__device__ __forceinline__ float wave_sum(float v) {
#pragma unroll
    for (int o = 1; o < 64; o <<= 1) v += __shfl_xor(v, o);
    return v;
}
__device__ __forceinline__ unsigned f2bf(float f) { unsigned u = __builtin_bit_cast(unsigned, f); return (u + 0x7fffu + ((u >> 16) & 1u)) >> 16; }
__device__ __forceinline__ unsigned pk2(float lo, float hi) { return f2bf(lo) | (f2bf(hi) << 16); }
__device__ __forceinline__ float bf_lo(unsigned w) { return __builtin_bit_cast(float, w << 16); }
__device__ __forceinline__ float bf_hi(unsigned w) { return __builtin_bit_cast(float, w & 0xffff0000u); }
#define LDS_WAIT() asm volatile("s_waitcnt lgkmcnt(0)" ::: "memory")

struct Args {
    const float *x, *c, *w_ada, *b_ada, *norm_mix, *w_in, *norm_a_out, *norm_c_out, *w_pool, *pool_scale, *rpb, *w_out, *norm_ffn, *w_ffn_in, *w_ffn_out, *norm_final;
    float* out; unsigned char* ws; int ph_lo, ph_hi;
};

template <bool SWG, bool ROT = false>
__device__ __forceinline__ void transpose_item(const float* W, int K, int N, bf16_t* WT, LAS float* scr, int item, int lane, const float* gsc = nullptr) {
    const int nblk = N / 32, kb = item / nblk, nb = item % nblk, k0 = 64 * kb, n0 = 32 * nb;
    int d0 = n0;
    if (SWG) { const int bj = n0 / FF, j = n0 % FF; d0 = 256 * (j / 128) + 128 * bj + (j % 128); }
    float tv[32];
#pragma unroll
    for (int i = 0; i < 32; ++i) tv[i] = W[(size_t)(k0 + 2 * i + (lane >> 5)) * N + n0 + (lane & 31)];
#pragma unroll
    for (int i = 0; i < 32; ++i) { float v = tv[i]; if (ROT && k0 >= 640) v *= gsc[k0 - 640 + 2 * i + (lane >> 5)]; scr[(2 * i + (lane >> 5)) * 33 + (lane & 31)] = v; }
    LDS_WAIT();
    const int c = lane & 7;
#pragma unroll
    for (int j = 0; j < 4; ++j) { const int n = (lane >> 3) + 8 * j; const LAS float* s = scr + (8 * c) * 33 + n;
        u32x4 o; o.x = pk2(s[0 * 33], s[1 * 33]); o.y = pk2(s[2 * 33], s[3 * 33]); o.z = pk2(s[4 * 33], s[5 * 33]); o.w = pk2(s[6 * 33], s[7 * 33]);
        *(u32x4*)(WT + (size_t)(d0 + n) * K + (ROT ? (k0 < 640 ? k0 + 384 : k0 - 640) : k0) + 8 * c) = o; }
    LDS_WAIT();
}

__device__ __forceinline__ void phase_p0(const Args& a, LAS unsigned char* lds, int tid, int lane, int wave) {
    float* mod = (float*)(a.ws + WS_MOD);
    for (int item = blockIdx.x; item < 192; item += gridDim.x) {
        LAS float* sc = (LAS float*)lds;
        LAS float* red = (LAS float*)(lds + 32768);
        for (int i = tid; i < 8192; i += NTHR) { const float v = a.c[i]; sc[(i & 1023) * 8 + (i >> 10)] = v / (1.0f + __expf(-v)); }
        __syncthreads();
        const int l = item / 96, cb = item % 96, col = cb * 64 + lane;
        const float* wp = a.w_ada + (size_t)l * DM * 6144 + (size_t)(wave * 128) * 6144 + col;
        float acc0 = 0.f, acc1 = 0.f, acc2 = 0.f, acc3 = 0.f, acc4 = 0.f, acc5 = 0.f, acc6 = 0.f, acc7 = 0.f;
#pragma unroll 16
        for (int k = 0; k < 128; ++k) {
            const float w = wp[(size_t)k * 6144];
            const f32x4 s0 = *(const LAS f32x4*)(sc + (wave * 128 + k) * 8), s1 = *(const LAS f32x4*)(sc + (wave * 128 + k) * 8 + 4);
            acc0 += w * s0[0]; acc1 += w * s0[1]; acc2 += w * s0[2]; acc3 += w * s0[3]; acc4 += w * s1[0]; acc5 += w * s1[1]; acc6 += w * s1[2]; acc7 += w * s1[3];
        }
        red[(wave * 8 + 0) * 64 + lane] = acc0; red[(wave * 8 + 1) * 64 + lane] = acc1; red[(wave * 8 + 2) * 64 + lane] = acc2; red[(wave * 8 + 3) * 64 + lane] = acc3;
        red[(wave * 8 + 4) * 64 + lane] = acc4; red[(wave * 8 + 5) * 64 + lane] = acc5; red[(wave * 8 + 6) * 64 + lane] = acc6; red[(wave * 8 + 7) * 64 + lane] = acc7;
        __syncthreads();
        { const int b = wave; float s = 0.f;
#pragma unroll
          for (int w = 0; w < 8; ++w) s += red[(w * 8 + b) * 64 + lane];
          mod[((size_t)l * NB + b) * 6144 + col] = s + a.b_ada[(size_t)l * 6144 + col]; }
        __syncthreads();
    }
    LAS float* scr = (LAS float*)(lds + wave * 16384);
    const int gw = blockIdx.x * NWAVES + wave, NGW = gridDim.x * NWAVES;
    constexpr int I_IN = (DM / 64) * (PW / 32), I_OUT = (DM / 64) * (DM / 32), I_FI = (DM / 64) * (2 * FF / 32), I_FO = (FF / 64) * (DM / 32), I_L = I_IN + I_OUT + I_FI + I_FO;
    for (int it = gw; it < NLAYER * I_L; it += NGW) {
        const int l = it / I_L; int r = it % I_L;
        unsigned char* wl = a.ws + WS_W + (size_t)l * W_LAYER;
        if (r < I_IN) { transpose_item<false>(a.w_in + (size_t)l * DM * PW, DM, PW, (bf16_t*)(wl + W_IN), scr, r, lane); continue; } r -= I_IN;
        if (r < I_OUT) { transpose_item<false, true>(a.w_out + (size_t)l * DM * DM, DM, DM, (bf16_t*)(wl + W_OUT), scr, r, lane, a.norm_c_out + l * 384); continue; } r -= I_OUT;
        if (r < I_FI) { transpose_item<true>(a.w_ffn_in + (size_t)l * DM * 2 * FF, DM, 2 * FF, (bf16_t*)(wl + W_FI), scr, r, lane); continue; } r -= I_FI;
        transpose_item<false>(a.w_ffn_out + (size_t)l * FF * DM, FF, DM, (bf16_t*)(wl + W_FO), scr, r, lane);
    }
}

template <bool FINAL>
__device__ __forceinline__ void norm_rows(const float* X, const float* g, const float* sc, const float* sh, bf16_t* H, float* outF, int gw, int NGW, int lane) {
    for (int cj = 0; 16 * (gw + NGW * (cj >> 3)) < MTOK; ++cj) {
        const int m = 16 * (gw + NGW * (cj >> 3)) + 2 * (cj & 7);
        const f32x4* xr = (const f32x4*)(X + (size_t)m * DM) + lane;
        f32x4 v[2][4]; float s0 = 0.f, s1 = 0.f;
#pragma unroll
        for (int j = 0; j < 4; ++j) { v[0][j] = xr[64 * j]; v[1][j] = xr[256 + 64 * j]; }
#pragma unroll
        for (int j = 0; j < 4; ++j) { s0 += (v[0][j][0] * v[0][j][0] + v[0][j][1] * v[0][j][1]) + (v[0][j][2] * v[0][j][2] + v[0][j][3] * v[0][j][3]);
                                      s1 += (v[1][j][0] * v[1][j][0] + v[1][j][1] * v[1][j][1]) + (v[1][j][2] * v[1][j][2] + v[1][j][3] * v[1][j][3]); }
        const float rstd0 = 1.0f / sqrtf(wave_sum(s0) * (1.0f / DM) + EPS), rstd1 = 1.0f / sqrtf(wave_sum(s1) * (1.0f / DM) + EPS);
        const int b = m >> 12;
#pragma unroll
        for (int j = 0; j < 4; ++j) { const int col = 4 * lane + 256 * j; const f32x4 gv = *(const f32x4*)(g + col);
            f32x4 y0 = v[0][j] * rstd0 * gv, y1 = v[1][j] * rstd1 * gv;
            if (FINAL) { *(f32x4*)(outF + (size_t)m * DM + col) = y0; *(f32x4*)(outF + (size_t)(m + 1) * DM + col) = y1; }
            else { const f32x4 scv = *(const f32x4*)(sc + (size_t)b * 6144 + col) + 1.0f, shv = *(const f32x4*)(sh + (size_t)b * 6144 + col);
                y0 = y0 * scv + shv; y1 = y1 * scv + shv; u32x2 w0, w1; w0.x = pk2(y0[0], y0[1]); w0.y = pk2(y0[2], y0[3]); w1.x = pk2(y1[0], y1[1]); w1.y = pk2(y1[2], y1[3]);
                *(u32x2*)(H + (size_t)m * DM + col) = w0; *(u32x2*)(H + (size_t)(m + 1) * DM + col) = w1; } }
    }
}


template <bool FINAL>
__device__ __forceinline__ void norm_rows_bf(const bf16_t* X, const float* g, const float* sc, const float* sh, bf16_t* H, float* outF, int gw, int NGW, int lane) {
    constexpr int NR = 4;
    u32x4 raw[NR][2], nxt[NR][2];
    static_assert(NR == 4, "row chunking below assumes 4 rows per iteration");
#define NRB_ROW(cj_) (16 * (gw + NGW * ((cj_) >> 2)) + NR * ((cj_) & 3))
    { const int m = NRB_ROW(0); if (m < MTOK) { const u32x4* xr = (const u32x4*)(X + (size_t)m * DM) + lane;
#pragma unroll
        for (int r = 0; r < NR; ++r) { raw[r][0] = xr[128 * r]; raw[r][1] = xr[128 * r + 64]; } } }
    for (int cj = 0; NRB_ROW(cj) < MTOK; ++cj) {
        const int m = NRB_ROW(cj);
        { const int mn = NRB_ROW(cj + 1) < MTOK ? NRB_ROW(cj + 1) : m; const u32x4* xn = (const u32x4*)(X + (size_t)mn * DM) + lane;
#pragma unroll
          for (int r = 0; r < NR; ++r) { nxt[r][0] = xn[128 * r]; nxt[r][1] = xn[128 * r + 64]; } }
        float ss[NR];
#pragma unroll
        for (int r = 0; r < NR; ++r) { ss[r] = 0.f;
#pragma unroll
            for (int j = 0; j < 2; ++j)
#pragma unroll
                for (int e = 0; e < 4; ++e) { const unsigned w = raw[r][j][e]; const float lo = bf_lo(w), hi = bf_hi(w); ss[r] += lo * lo + hi * hi; } }
        float rstd[NR];
#pragma unroll
        for (int r = 0; r < NR; ++r) rstd[r] = 1.0f / sqrtf(wave_sum(ss[r]) * (1.0f / DM) + EPS);
        const int b = m >> 12;
#pragma unroll
        for (int j = 0; j < 2; ++j) { const int col = 8 * lane + 512 * j;
            float gg[8], aa[8], bb[8];
#pragma unroll
            for (int q = 0; q < 2; ++q) { const f32x4 gv = *(const f32x4*)(g + col + 4 * q);
                f32x4 scv = (f32x4){0.f, 0.f, 0.f, 0.f}, shv = scv;
                if (!FINAL) { scv = *(const f32x4*)(sc + (size_t)b * 6144 + col + 4 * q); shv = *(const f32x4*)(sh + (size_t)b * 6144 + col + 4 * q); }
#pragma unroll
                for (int e = 0; e < 4; ++e) { gg[4 * q + e] = gv[e]; aa[4 * q + e] = 1.0f + scv[e]; bb[4 * q + e] = shv[e]; } }
#pragma unroll
            for (int r = 0; r < NR; ++r) {
                float y[8];
#pragma unroll
                for (int e = 0; e < 4; ++e) { const unsigned w = raw[r][j][e]; y[2 * e] = bf_lo(w) * rstd[r] * gg[2 * e]; y[2 * e + 1] = bf_hi(w) * rstd[r] * gg[2 * e + 1]; }
                if (!FINAL) {
#pragma unroll
                    for (int e = 0; e < 8; ++e) y[e] = y[e] * aa[e] + bb[e]; }
                if (FINAL) { float* o = outF + (size_t)(m + r) * DM + col; *(f32x4*)o = (f32x4){y[0], y[1], y[2], y[3]}; *(f32x4*)(o + 4) = (f32x4){y[4], y[5], y[6], y[7]}; }
                else { u32x4 w; w.x = pk2(y[0], y[1]); w.y = pk2(y[2], y[3]); w.z = pk2(y[4], y[5]); w.w = pk2(y[6], y[7]); *(u32x4*)(H + (size_t)(m + r) * DM + col) = w; } } }
#pragma unroll
        for (int r = 0; r < NR; ++r) { raw[r][0] = nxt[r][0]; raw[r][1] = nxt[r][1]; }
    }
#undef NRB_ROW
}
#define LDS_BARRIER() asm volatile("s_waitcnt lgkmcnt(0)\n\ts_barrier" ::: "memory")
__device__ __forceinline__ void pool_phase(const Args& a, int l, LAS unsigned char* lds, int tid, int vb) {
    const bf16_t* UB = (const bf16_t*)(a.ws + WS_Z) + UB_OFF_E; bf16_t* MIX = (bf16_t*)(a.ws + WS_Z) + MIX_OFF_E;
    constexpr int PLP = 528, WTP = 144;
    LAS bf16_t* us = (LAS bf16_t*)lds;
    LAS unsigned char* plb = lds + 40960;
    LAS unsigned char* wt = lds + 40960 + 64 * PLP;
    static_assert(40960 + 64 * PLP + 256 * WTP <= 131072, "pool LDS map");
    const int G = gridDim.x; const bool xa = (G == 256);
    int unit = xa ? (vb & 7) * 64 + (vb >> 3) : vb; const int ustep = xa ? 32 : G, uend = xa ? (vb & 7) * 64 + 64 : 512;
    if (unit >= uend) return;
    const int c = tid & 255, g = c >> 6, th = tid >> 8, hw = 1 << g;
    const int wave = tid >> 6, lane = tid & 63, r = lane & 31, hh = lane >> 5, mg = wave & 3, mt = wave >> 2;
    { const float* wp = a.w_pool + (size_t)l * 4 * 4096;
      for (int i = tid; i < 4 * 4096; i += NTHR) { const int gg = i >> 12, cc = (i >> 6) & 63, dd = i & 63; *(LAS bf16_t*)(wt + (gg * 64 + dd) * WTP + cc * 2) = (bf16_t)f2bf(wp[i]); } }
    const float psc0 = a.pool_scale[l * 256 + mg * 64 + r], psc1 = a.pool_scale[l * 256 + mg * 64 + 32 + r];
    u32x4 pre[5];
#define POOL_LOAD(unit_) do { const int b_ = (unit_) >> 6, t0_ = ((unit_) & 63) * 64; _Pragma("unroll") for (int i_ = 0; i_ < 5; ++i_) { const int q_ = tid + NTHR * i_, rr_ = q_ >> 5, ch_ = q_ & 31, t_ = t0_ - 8 + rr_; \
        pre[i_] = (u32x4){0u, 0u, 0u, 0u}; if (t_ >= 0 && t_ < SEQ) pre[i_] = *(const u32x4*)(UB + (size_t)b_ * BLK_E + (size_t)t_ * 256 + ch_ * 8); } } while (0)
    POOL_LOAD(unit);
#define US(row_) __builtin_bit_cast(float, (unsigned)us[(row_) * 256 + c] << 16)
    for (; unit < uend; unit += ustep) {
        const int b = unit >> 6, t0 = (unit & 63) * 64;
        LDS_BARRIER();
#pragma unroll
        for (int i = 0; i < 5; ++i) { const int q = tid + NTHR * i, rr = q >> 5, ch = q & 31; *(LAS u32x4*)(us + rr * 256 + ch * 8) = pre[i]; }
        LDS_BARRIER();
        if (unit + ustep < uend) POOL_LOAD(unit + ustep);
        { const int tt0 = th * 32; float s = 0.f;
          for (int q = tt0 + 8 - hw; q <= tt0 + 8 + hw - 1; ++q) s += US(q);
          for (int tt = tt0; tt < tt0 + 32; tt += 4) {
              float av[4], bv[4], cv[4], ic[4];
#pragma unroll
              for (int e = 0; e < 4; ++e) { av[e] = US(tt + e + 8 + hw); bv[e] = US(tt + e + 8 - hw); cv[e] = US(tt + e + 8);
                  const int t = t0 + tt + e; int lo = t - hw; if (lo < 0) lo = 0; int hi = t + hw - 1; if (hi > SEQ - 1) hi = SEQ - 1; ic[e] = __builtin_amdgcn_rcpf((float)(hi - lo + 1)); }
#pragma unroll
              for (int e = 0; e < 4; ++e) { *(LAS bf16_t*)(plb + (tt + e) * PLP + c * 2) = (bf16_t)f2bf(s * ic[e] - cv[e]); s += av[e] - bv[e]; } } }
        LDS_BARRIER();
        {
          const LAS unsigned char* ap = plb + (32 * mt + r) * PLP + (mg * 64 + 8 * hh) * 2;
          const LAS unsigned char* bp = wt + (mg * 64 + r) * WTP + (8 * hh) * 2;
          f32x16 y0, y1;
#pragma unroll
          for (int i = 0; i < 16; ++i) { y0[i] = 0.f; y1[i] = 0.f; }
#pragma unroll
          for (int s4 = 0; s4 < 4; ++s4) { const bf16x8 af = *(const LAS bf16x8*)(ap + 32 * s4), b0 = *(const LAS bf16x8*)(bp + 32 * s4), b1 = *(const LAS bf16x8*)(bp + 32 * WTP + 32 * s4);
              y0 = __builtin_amdgcn_mfma_f32_32x32x16_bf16(af, b0, y0, 0, 0, 0); y1 = __builtin_amdgcn_mfma_f32_32x32x16_bf16(af, b1, y1, 0, 0, 0); }
          bf16_t* op = MIX + (size_t)b * BLK_E + (size_t)(t0 + 32 * mt + 4 * hh) * DM + 768 + mg * 64 + r;
#pragma unroll
          for (int i = 0; i < 16; ++i) { const int tk = (i & 3) + 8 * (i >> 2); op[(size_t)tk * DM] = (bf16_t)f2bf(y0[i] * psc0); op[(size_t)tk * DM + 32] = (bf16_t)f2bf(y1[i] * psc1); } }
    }
#undef US
#undef POOL_LOAD
    __syncthreads();
}

constexpr int VP = 144;
constexpr int KT_OFF = 0, VT_OFF = 384 * VP, RPB_OFF = 2 * 384 * VP, QT_OFF = 121856;
static_assert(RPB_OFF + 6 * 15 * 31 * 4 <= QT_OFF && QT_OFF + 256 * VP <= LDS_XB_OFF, "attention LDS map");
constexpr int BT_OFF = LDS_XB_OFF + 128;
static_assert(BT_OFF + 192 * 4 <= LDS_BYTES, "bias table");
struct PassDesc { int mode, b, h, ls, res, i0, r0, sub; };
#define D_KRLO(d_) rstart_of((d_).r0)
#define D_KRHI(d_) (rstart_of((d_).r0 + 3) + 7)
__device__ __forceinline__ int rstart_of(int r) { int s = r - 4; return s < 0 ? 0 : (s > 56 ? 56 : s); }
__device__ __forceinline__ s16x4 vtr(const LAS unsigned char* p) { return __builtin_bit_cast(s16x4, __builtin_amdgcn_ds_read_tr16_b64_v4i16((LAS s16x4*)p)); }
constexpr int NA_UNITS = 48 * 3 * 16, NC_UNITS = 48 * 16;

__device__ __forceinline__ void get_pass(int s, int nA, PassDesc& d, int vb) {
    const int x = vb & 7, li = vb >> 3, G = gridDim.x; const bool xa = (G == 256);
    d.mode = 0; d.b = 0; d.h = 0; d.ls = 0; d.res = 0; d.i0 = 0; d.r0 = 0; d.sub = 0;
    if (s < nA) { const int ia = xa ? li + 32 * s : vb + s * G, bh = (xa ? 6 * x : 0) + ia / 48, u = ia % 48, br = u >> 4, q = u & 15; d.mode = 0; d.b = bh / 6; d.h = bh % 6; d.ls = 2 * br;
        const int cpr = 16 >> d.ls;
        d.res = q / cpr; d.i0 = (q % cpr) * 256; }
    else { const int c = s - nA, ic = xa ? li + 32 * (c >> 1) : vb + (c >> 1) * G, bh = (xa ? 6 * x : 0) + ic / 16, quad = ic & 15; d.mode = 1; d.b = bh / 6; d.h = bh % 6; d.sub = c & 1; d.r0 = 4 * quad; }
}
__device__ __forceinline__ int pass_qtok(const PassDesc& d, int wave, int lane) {
    const int r = lane & 31;
    return d.mode == 0 ? (((d.i0 + 32 * wave + r) << d.ls) + d.res) : ((d.r0 + 2 * (wave >> 2) + (r >> 4)) * 64 + 16 * (wave & 3) + (r & 15));
}
__device__ __forceinline__ void attn_load_kv(const PassDesc& d, const bf16_t* Z, int tid, u32x4 (&kr)[6], u32x4 (&vr)[6]) {
    const bf16_t* Kb = Z + (size_t)d.b * BLK_E + (size_t)(d.mode == 0 ? 1 : 4) * ZSEG + (size_t)d.h * SEQ * 64;
    const int n = SEQ >> d.ls;
    int tq_ = tid; asm volatile("" : "+v"(tq_));
#pragma unroll
    for (int i = 0; i < 6; ++i) { const int q = tq_ + NTHR * i, row = q >> 3, ch = q & 7; int tok;
        if (d.mode == 0) { int j = d.i0 - 64 + row; j = j < 0 ? 0 : (j > n - 1 ? n - 1 : j); tok = (j << d.ls) + d.res; }
        else { const int krhi_ = D_KRHI(d); int kr_ = D_KRLO(d) + 6 * d.sub + (row >> 6); kr_ = kr_ > krhi_ ? krhi_ : kr_; tok = kr_ * 64 + (row & 63); }
        const bf16_t* p = Kb + tok * 64 + ch * 8; kr[i] = *(const u32x4*)p; vr[i] = *(const u32x4*)(p + ZSEG); }
}
__device__ __forceinline__ void attn_load_q(const PassDesc& d, const bf16_t* Z, int wave, int lane, bf16x8 (&qf)[4]) {
    const bf16_t* qp = Z + (size_t)d.b * BLK_E + (size_t)(d.mode == 0 ? 0 : 3) * ZSEG + ((size_t)d.h * SEQ + pass_qtok(d, wave, lane)) * 64 + 8 * (lane >> 5);
#pragma unroll
    for (int s = 0; s < 4; ++s) qf[s] = *(const bf16x8*)(qp + 16 * s);
}
__device__ __forceinline__ void attn_stage(LAS unsigned char* lds, int tid, const u32x4 (&kr)[6], const u32x4 (&vr)[6], const bf16x8 (&qf)[4]) {
    { const int wave_ = tid >> 6, lane_ = tid & 63; LAS unsigned char* qp_ = lds + QT_OFF + (32 * wave_ + (lane_ & 31)) * VP + 16 * (lane_ >> 5);
#pragma unroll
      for (int s_ = 0; s_ < 4; ++s_) *(LAS bf16x8*)(qp_ + 32 * s_) = qf[s_]; }
    int ts_ = tid; asm volatile("" : "+v"(ts_));
#pragma unroll
    for (int i = 0; i < 6; ++i) { const int q = ts_ + NTHR * i, row = q >> 3, ch = q & 7;
        *(LAS u32x4*)(lds + KT_OFF + row * VP + ch * 16) = kr[i]; *(LAS u32x4*)(lds + VT_OFF + row * VP + ch * 16) = vr[i]; }
}

struct AttnLane { int r, hh, n, qi, rq, cq, cstart, rs, kc0; float slope2, mid, hwid; };

template <int MODE, int NT>
__device__ __forceinline__ void attn_step(const PassDesc& d, const AttnLane& L, LAS unsigned char* lds, const LAS float* rpbl, float& m, float& l, f32x16& o0, f32x16& o1, int wave, int lane, int st) {
    typedef float f32x2 __attribute__((ext_vector_type(2)));
    const int r = L.r, hh = L.hh;
    int rowbase[NT], jb[NT], krow[NT];
#pragma unroll
    for (int t = 0; t < NT; ++t) { rowbase[t] = (MODE == 0) ? 32 * (wave + st + t) : 64 * (st + t) + L.kc0; jb[t] = d.i0 - 64 + rowbase[t]; krow[t] = D_KRLO(d) + 6 * d.sub + st + t; }
    f32x16 sa[NT];
#pragma unroll
    for (int t = 0; t < NT; ++t) { const LAS unsigned char* kp = lds + KT_OFF + (rowbase[t] + r) * VP + 16 * hh; const LAS unsigned char* qp = lds + QT_OFF + (32 * wave + r) * VP + 16 * hh; bf16x8 kf[4], qf[4];
#pragma unroll
        for (int s = 0; s < 4; ++s) { kf[s] = *(const LAS bf16x8*)(kp + 32 * s); qf[s] = *(const LAS bf16x8*)(qp + 32 * s); }
#pragma unroll
        for (int i = 0; i < 16; ++i) sa[t][i] = 0.f;
#pragma unroll
        for (int s = 0; s < 4; ++s) sa[t] = __builtin_amdgcn_mfma_f32_32x32x16_bf16(kf[s], qf[s], sa[t], 0, 0, 0);
        __builtin_amdgcn_sched_barrier(0); }
    float mloc = -1e30f;
#pragma unroll
    for (int t = 0; t < NT; ++t) {
        if (MODE == 0) {
            if (jb[t] >= 0 && jb[t] + 31 < L.n) {
                const LAS float* bp = (const LAS float*)(lds + BT_OFF) + (jb[t] + 4 * hh - L.qi + 95);
                float bias[16];
#pragma unroll
                for (int i = 0; i < 16; ++i) bias[i] = bp[(i & 3) + 8 * (i >> 2)];
#pragma unroll
                for (int i = 0; i < 16; ++i) sa[t][i] += bias[i];
            } else {
            const float rel0 = (float)(jb[t] + 4 * hh - L.qi);
            const f32x2 r2 = (f32x2){rel0, rel0}, m2 = (f32x2){rel0 - L.mid, rel0 - L.mid}, ns2 = (f32x2){-L.slope2, -L.slope2};
#pragma unroll
            for (int i = 0; i < 16; i += 2) { const f32x2 c2 = (f32x2){(float)((i & 3) + 8 * (i >> 2)), (float)(((i + 1) & 3) + 8 * ((i + 1) >> 2))};
                const f32x2 rel = r2 + c2, rc = m2 + c2; const f32x2 ar = (f32x2){__builtin_fabsf(rel.x), __builtin_fabsf(rel.y)};
                const f32x2 s2 = ar * ns2 + (f32x2){sa[t][i], sa[t][i + 1]};
                sa[t][i] = (__builtin_fabsf(rc.x) <= L.hwid) ? s2.x : -1e30f; sa[t][i + 1] = (__builtin_fabsf(rc.y) <= L.hwid) ? s2.y : -1e30f; }
            }
        } else {
            const LAS float* bp = rpbl + (d.h * 15 + (krow[t] - L.rq + 7)) * 31 + (L.kc0 + 4 * hh - L.cq + 15);
            float bias[16];
#pragma unroll
            for (int i = 0; i < 16; ++i) bias[i] = bp[(i & 3) + 8 * (i >> 2)];
            const bool rok = (krow[t] >= L.rs) && (krow[t] <= L.rs + 7); const float cm = rok ? (float)(L.cstart - L.kc0 - 4 * hh) + 7.5f : 1e9f;
#pragma unroll
            for (int i = 0; i < 16; ++i) { const float ci = (float)((i & 3) + 8 * (i >> 2)); const float s = sa[t][i] + bias[i]; sa[t][i] = (__builtin_fabsf(ci - cm) <= 7.5f) ? s : -1e30f; }
        }
#pragma unroll
        for (int i = 0; i < 16; ++i) mloc = fmaxf(mloc, sa[t][i]);
    }
    mloc = fmaxf(mloc, __shfl_xor(mloc, 32));
    const float mn = fmaxf(m, mloc), alpha = __builtin_amdgcn_exp2f(m - mn); m = mn;
    float ps = 0.f;
#pragma unroll
    for (int t = 0; t < NT; ++t)
#pragma unroll
        for (int i = 0; i < 16; ++i) { sa[t][i] = __builtin_amdgcn_exp2f(sa[t][i] - mn); ps += sa[t][i]; }
    l = l * alpha + ps;
#pragma unroll
    for (int i = 0; i < 16; ++i) { o0[i] *= alpha; o1[i] *= alpha; }
#pragma unroll
    for (int t = 0; t < NT; ++t) {
        bf16x8 pb[2];
#pragma unroll
        for (int s2 = 0; s2 < 2; ++s2) { u32x4 w; w.x = pg8::cvt_pk_bf16(sa[t][8 * s2 + 0], sa[t][8 * s2 + 1]); w.y = pg8::cvt_pk_bf16(sa[t][8 * s2 + 2], sa[t][8 * s2 + 3]);
            w.z = pg8::cvt_pk_bf16(sa[t][8 * s2 + 4], sa[t][8 * s2 + 5]); w.w = pg8::cvt_pk_bf16(sa[t][8 * s2 + 6], sa[t][8 * s2 + 7]); pb[s2] = __builtin_bit_cast(bf16x8, w); }
        __builtin_amdgcn_sched_barrier(0);
        const LAS unsigned char* vb = lds + VT_OFF + (rowbase[t] + 4 * hh + ((lane & 15) >> 2)) * VP + (16 * (r >> 4) + 4 * (lane & 3)) * 2;
#pragma unroll
        for (int s2 = 0; s2 < 2; ++s2) {
            const s16x4 a00 = vtr(vb + (16 * s2) * VP), a01 = vtr(vb + (16 * s2 + 8) * VP), a10 = vtr(vb + (16 * s2) * VP + 64), a11 = vtr(vb + (16 * s2 + 8) * VP + 64);
            const bf16x8 A0 = (bf16x8){a00[0], a00[1], a00[2], a00[3], a01[0], a01[1], a01[2], a01[3]}, A1 = (bf16x8){a10[0], a10[1], a10[2], a10[3], a11[0], a11[1], a11[2], a11[3]};
            o0 = __builtin_amdgcn_mfma_f32_32x32x16_bf16(A0, pb[s2], o0, 0, 0, 0);
            o1 = __builtin_amdgcn_mfma_f32_32x32x16_bf16(A1, pb[s2], o1, 0, 0, 0); } }
}

template <int MODE>
__device__ __forceinline__ void attn_compute(const PassDesc& d, LAS unsigned char* lds, const LAS float* rpbl, float& m, float& l, f32x16& o0, f32x16& o1, int wave, int lane) {
    AttnLane L; L.r = lane & 31; L.hh = lane >> 5;
    L.n = SEQ >> d.ls; L.qi = d.i0 + 32 * wave + L.r;
    L.slope2 = exp2f(-8.0f * (float)(d.h + 1) / 6.0f) * LOG2E * (float)(1 << d.ls);
    { const float lo = fmaxf(-64.0f, (float)(-L.qi)), hi = fminf(64.0f, (float)(L.n - 1 - L.qi)); L.mid = 0.5f * (lo + hi); L.hwid = 0.5f * (hi - lo); }
    const int pair = wave >> 2, g = wave & 3; L.rq = d.r0 + 2 * pair + (L.r >> 4); L.cq = 16 * g + (L.r & 15);
    { int cs = L.cq - 8; L.cstart = cs < 0 ? 0 : (cs > 48 ? 48 : cs); }
    L.rs = rstart_of(L.rq); L.kc0 = (g == 0) ? 0 : (g == 1 ? 8 : (g == 2 ? 24 : 32));
    const int wlo = rstart_of(d.r0 + 2 * pair), whi = rstart_of(d.r0 + 2 * pair + 1) + 7;
    constexpr int NST = (MODE == 0) ? 5 : 6;
    int s_lo = NST, s_hi = 0;
#pragma unroll
    for (int st = 0; st < NST; ++st) { bool act;
        if (MODE == 0) { const int jb_ = d.i0 - 64 + 32 * (wave + st); act = !(jb_ + 31 < 0 || jb_ >= L.n); }
        else { const int kr_ = D_KRLO(d) + 6 * d.sub + st; act = !(kr_ > D_KRHI(d) || kr_ < wlo || kr_ > whi); }
        if (act) { s_lo = st < s_lo ? st : s_lo; s_hi = st + 1; } }
#pragma unroll 1
    for (int st = s_lo; st < s_hi; st += 2) {
        if (st + 1 < s_hi) attn_step<MODE, 2>(d, L, lds, rpbl, m, l, o0, o1, wave, lane, st);
        else attn_step<MODE, 1>(d, L, lds, rpbl, m, l, o0, o1, wave, lane, st);
    }
}
__device__ __forceinline__ void attn_final(const Args& a, const PassDesc& d, float m, float l, const f32x16& o0, const f32x16& o1, int wave, int lane) {
    const int hh = lane >> 5, tq = pass_qtok(d, wave, lane);
    const float lt = l + __shfl_xor(l, 32), inv = 1.0f / lt;
    bf16_t* op = d.mode == 0 ? (bf16_t*)(a.ws + WS_OBR + (size_t)(d.ls >> 1) * OBR_STRIDE) + ((size_t)d.b * SEQ + tq) * 384 + d.h * 64 + 4 * hh
                             : (bf16_t*)(a.ws + WS_Z) + MIX_OFF_E + (size_t)d.b * BLK_E + (size_t)tq * DM + d.h * 64 + 4 * hh;
    float ss = 0.f;
#pragma unroll
    for (int g4 = 0; g4 < 4; ++g4) {
        u32x2 w0, w1; w0.x = pk2(o0[4 * g4] * inv, o0[4 * g4 + 1] * inv); w0.y = pk2(o0[4 * g4 + 2] * inv, o0[4 * g4 + 3] * inv);
        w1.x = pk2(o1[4 * g4] * inv, o1[4 * g4 + 1] * inv); w1.y = pk2(o1[4 * g4 + 2] * inv, o1[4 * g4 + 3] * inv);
        ss += (bf_lo(w0.x) * bf_lo(w0.x) + bf_hi(w0.x) * bf_hi(w0.x)) + (bf_lo(w0.y) * bf_lo(w0.y) + bf_hi(w0.y) * bf_hi(w0.y));
        ss += (bf_lo(w1.x) * bf_lo(w1.x) + bf_hi(w1.x) * bf_hi(w1.x)) + (bf_lo(w1.y) * bf_lo(w1.y) + bf_hi(w1.y) * bf_hi(w1.y));
        *(u32x2*)(op + 8 * g4) = w0; *(u32x2*)(op + 32 + 8 * g4) = w1; }
    if (d.mode == 1) { ss += __shfl_xor(ss, 32); if (hh == 0) ((float*)(a.ws + WS_SSC))[((size_t)d.b * SEQ + tq) * 6 + d.h] = ss; }
    if (d.mode == 0 && hh == 0) ((float*)(a.ws + WS_LSE))[((size_t)(d.ls >> 1) * MTOK + (size_t)d.b * SEQ + tq) * 6 + d.h] = (m + __log2f(lt)) * LN2;
}

__device__ __forceinline__ void phase_mix(const Args& a, int l, LAS unsigned char* lds, int tid, int lane, int wave, int vb) {
    pool_phase(a, l, lds, tid, vb);
    LAS float* rpbl = (LAS float*)(lds + RPB_OFF);
    for (int i = tid; i < 6 * 15 * 31; i += NTHR) rpbl[i] = a.rpb[(size_t)l * 2790 + i] * LOG2E;
    const bf16_t* Z = (const bf16_t*)(a.ws + WS_Z);
    const int G = gridDim.x, bx = vb;
    const int nA = (G == 256) ? 9 : (bx < NA_UNITS ? (NA_UNITS - bx + G - 1) / G : 0), nC = (G == 256) ? 3 : (bx < NC_UNITS ? (NC_UNITS - bx + G - 1) / G : 0), npass = nA + 2 * nC;
    PassDesc cur, nxt; u32x4 kr[6], vr[6]; bf16x8 qc[4];
    float m = -1e30f, lsum = 0.f; f32x16 o0, o1;
#pragma unroll
    for (int i = 0; i < 16; ++i) { o0[i] = 0.f; o1[i] = 0.f; }
    get_pass(0, nA, cur, vb); nxt = cur;
    if (npass > 0) { attn_load_kv(cur, Z, tid, kr, vr); attn_load_q(cur, Z, wave, lane, qc); }
#pragma unroll 1
    for (int s = 0; s < npass; ++s) {
        LDS_BARRIER();
        attn_stage(lds, tid, kr, vr, qc);
        if (cur.mode == 0 && tid < 191) { const float sl = exp2f(-8.0f * (float)(cur.h + 1) / 6.0f) * LOG2E * (float)(1 << cur.ls); const int ar = tid < 95 ? 95 - tid : tid - 95;
            ((LAS float*)(lds + BT_OFF))[tid] = ar <= 64 ? -sl * (float)ar : -1e30f; }
        LDS_BARRIER();
        if (s + 1 < npass) { get_pass(s + 1, nA, nxt, vb); attn_load_kv(nxt, Z, tid, kr, vr); attn_load_q(nxt, Z, wave, lane, qc); }
        if (cur.mode == 0 || cur.sub == 0) { m = -1e30f; lsum = 0.f;
#pragma unroll
            for (int i = 0; i < 16; ++i) { o0[i] = 0.f; o1[i] = 0.f; } }
        if (cur.mode == 0) attn_compute<0>(cur, lds, rpbl, m, lsum, o0, o1, wave, lane);
        else attn_compute<1>(cur, lds, rpbl, m, lsum, o0, o1, wave, lane);
        if (cur.mode == 0 || cur.sub == 1) attn_final(a, cur, m, lsum, o0, o1, wave, lane);
        cur = nxt;
    }
    __syncthreads();
}

__device__ __forceinline__ void phase_combine(const Args& a, int l, int lane, int gw, int NGW) {
    const bf16_t* __restrict__ OB = (const bf16_t*)(a.ws + WS_OBR); const float* __restrict__ LSE = (const float*)(a.ws + WS_LSE); bf16_t* __restrict__ MIX = (bf16_t*)(a.ws + WS_Z) + MIX_OFF_E;
    constexpr size_t OS = OBR_STRIDE / 2; constexpr int NT = 4;
    const bool act = lane < 48; const int ch = act ? 8 * lane : 0, hd = ch >> 6;
    float ga[8];
    { const f32x4 a0 = *(const f32x4*)(a.norm_a_out + l * 384 + ch), a1 = *(const f32x4*)(a.norm_a_out + l * 384 + ch + 4);
#pragma unroll
      for (int e = 0; e < 4; ++e) { ga[e] = a0[e]; ga[4 + e] = a1[e]; } }
    for (int cj = 0; 16 * (gw + NGW * (cj >> 2)) < MTOK; ++cj) {
        const int tok0 = 16 * (gw + NGW * (cj >> 2)) + NT * (cj & 3);
        u32x4 w[NT][3]; float ls[NT][3];
#pragma unroll
        for (int t = 0; t < NT; ++t) { const size_t tok = tok0 + t;
#pragma unroll
            for (int br = 0; br < 3; ++br) w[t][br] = *(const u32x4*)(OB + br * OS + tok * 384 + ch);
#pragma unroll
            for (int br = 0; br < 3; ++br) ls[t][br] = LSE[((size_t)br * MTOK + tok) * 6 + hd]; }
#pragma unroll
        for (int t = 0; t < NT; ++t) { const size_t tok = tok0 + t;
            const float l0 = ls[t][0], l1 = ls[t][1], l2 = ls[t][2];
            const float mx = fmaxf(l0, fmaxf(l1, l2)), e0 = __expf(l0 - mx), e1 = __expf(l1 - mx), e2 = __expf(l2 - mx), inv = 1.0f / (e0 + e1 + e2);
            float va[8]; float ssa = 0.f;
#pragma unroll
            for (int e = 0; e < 4; ++e) { const unsigned w0 = w[t][0][e], w1 = w[t][1][e], w2 = w[t][2][e];
                va[2 * e] = (e0 * bf_lo(w0) + e1 * bf_lo(w1) + e2 * bf_lo(w2)) * inv; va[2 * e + 1] = (e0 * bf_hi(w0) + e1 * bf_hi(w1) + e2 * bf_hi(w2)) * inv;
                ssa += va[2 * e] * va[2 * e] + va[2 * e + 1] * va[2 * e + 1]; }
            if (!act) ssa = 0.f;
            const float ra = 1.0f / sqrtf(wave_sum(ssa) * (1.0f / 384.0f) + EPS);
            if (act) { u32x4 oa;
#pragma unroll
                for (int e = 0; e < 4; ++e) oa[e] = pk2(va[2 * e] * ra * ga[2 * e], va[2 * e + 1] * ra * ga[2 * e + 1]);
                *(u32x4*)(MIX + (tok >> 12) * BLK_E + (tok & 4095) * DM + 384 + ch) = oa; } }
    }
}

#define XB_TMO      128
#define XB_XCNT(j)  (256  + 64 * (j))
#define XB_XSUB(j)  (1280 + 64 * (j))
#define XB_XGEN(j)  (2304 + 64 * (j))
#define XB_TOP      3328
#define XB_TOPGEN   3392
#define XCD_BAR_WORDS 3456
#define XB_SPIN_CAP (1u << 18)

__device__ __forceinline__ unsigned xb_ld(unsigned* p)              { return __hip_atomic_load(p, __ATOMIC_RELAXED, __HIP_MEMORY_SCOPE_AGENT); }
__device__ __forceinline__ unsigned xb_add(unsigned* p, unsigned v) { return __hip_atomic_fetch_add(p, v, __ATOMIC_RELAXED, __HIP_MEMORY_SCOPE_AGENT); }
__device__ __forceinline__ unsigned xb_xcc_id() { return (unsigned)__builtin_amdgcn_s_getreg((3 << 11) | 20) & 0xFu; }
#define XB_SPIN(cond, bar) do { unsigned _sp = 0; while (cond) { __builtin_amdgcn_s_sleep(1); \
    if ((++_sp & 255u) == 0u) { if (xb_ld(&(bar)[XB_TMO])) break; if (_sp > XB_SPIN_CAP) { atomicAdd(&(bar)[XB_TMO], 1u); break; } } } } while (0)

struct XcdBarrier {
    unsigned* bar; unsigned x;
    volatile LAS unsigned* st;
};

__device__ __forceinline__ XcdBarrier xcd_barrier_post(unsigned* bar, volatile LAS unsigned* st) {
    XcdBarrier b; b.bar = bar; b.x = xb_xcc_id(); b.st = st;
    if (threadIdx.x == 0) st[2] = xb_add(&bar[XB_XCNT(b.x)], 1u);
    return b;
}
__device__ __forceinline__ void xcd_barrier_complete(unsigned* bar, unsigned x, unsigned& nloc, unsigned& nx, unsigned& reg) {
    const unsigned G = gridDim.x * gridDim.y * gridDim.z;
    unsigned sum, cnt, mine, sp = 0u;
    for (;;) {
        sum = 0u; cnt = 0u; mine = 0u;
#pragma unroll
        for (unsigned j = 0; j < 16; ++j) { const unsigned c = xb_ld(&bar[XB_XCNT(j)]); sum += c; cnt += (c > 0u) ? 1u : 0u; mine = (j == x) ? c : mine; }
        if (sum == G) break;
        __builtin_amdgcn_s_sleep(1);
        if ((++sp & 255u) == 0u) { if (xb_ld(&bar[XB_TMO])) break; if (sp > XB_SPIN_CAP) { atomicAdd(&bar[XB_TMO], 1u); break; } }
    }
    nloc = mine > 0u ? mine : 1u; nx = cnt > 0u ? cnt : 1u;
    { unsigned ok = (sum == G && G == 256u && x < 8u) ? 1u : 0u;
#pragma unroll
      for (unsigned j = 0; j < 16; ++j) { const unsigned c = xb_ld(&bar[XB_XCNT(j)]); if (c != (j < 8u ? 32u : 0u)) ok = 0u; }
      reg = ok; }
}

__device__ __forceinline__ void xcd_barrier(const XcdBarrier& b) {
    asm volatile("s_waitcnt vmcnt(0)" ::: "memory");
    __syncthreads();
    if (threadIdx.x == 0) {
        unsigned* bar = b.bar;
        __builtin_amdgcn_s_waitcnt(0);
        unsigned nloc = b.st[0], nx = b.st[1];
        if (nloc == 0u) { unsigned reg = 0u; xcd_barrier_complete(bar, b.x, nloc, nx, reg); b.st[0] = nloc; b.st[1] = nx; b.st[3] = reg; }
        const unsigned old = xb_add(&bar[XB_XSUB(b.x)], 1u);
        const unsigned gen = old / nloc;
        if (old + 1u == (gen + 1u) * nloc) {
            __builtin_amdgcn_fence(__ATOMIC_RELEASE, "agent");
            asm volatile("s_waitcnt vmcnt(0)" ::: "memory");
            const unsigned og = xb_add(&bar[XB_TOP], 1u);
            const unsigned tg = og / nx;
            if (og + 1u == (tg + 1u) * nx) xb_add(&bar[XB_TOPGEN], 1u);
            else XB_SPIN(xb_ld(&bar[XB_TOPGEN]) == tg, bar);
            __builtin_amdgcn_fence(__ATOMIC_ACQUIRE, "agent");
            xb_add(&bar[XB_XGEN(b.x)], 1u);
            asm volatile("s_waitcnt vmcnt(0)" ::: "memory");
        } else {
            XB_SPIN(xb_ld(&bar[XB_XGEN(b.x)]) == gen, bar);
            __builtin_amdgcn_fence(__ATOMIC_ACQUIRE, "agent");
            asm volatile("s_waitcnt vmcnt(0)" ::: "memory");
        }
    }
    __syncthreads();
}

__device__ __forceinline__ void xcd_barrier_local(const XcdBarrier& b) {
    asm volatile("s_waitcnt vmcnt(0)" ::: "memory");
    __syncthreads();
    if (threadIdx.x == 0) {
        unsigned* bar = b.bar;
        __builtin_amdgcn_s_waitcnt(0);
        const unsigned nloc = b.st[0];
        const unsigned old = xb_add(&bar[XB_XSUB(b.x)], 1u);
        const unsigned gen = old / nloc;
        if (old + 1u == (gen + 1u) * nloc) xb_add(&bar[XB_XGEN(b.x)], 1u);
        else XB_SPIN(xb_ld(&bar[XB_XGEN(b.x)]) == gen, bar);
        __builtin_amdgcn_fence(__ATOMIC_ACQUIRE, "agent");
        asm volatile("s_waitcnt vmcnt(0)" ::: "memory");
    }
    __syncthreads();
}
#ifndef PH_MASK
#define PH_MASK 0x3ff
#endif
#ifndef REP_MASK
#define REP_MASK 0
#endif
constexpr unsigned REPM = REP_MASK;
constexpr unsigned PHM = PH_MASK;
constexpr int N_PHASES = 18;
__global__ void __launch_bounds__(NTHR, 2) fwd_mega(Args a) {
    extern __shared__ __attribute__((aligned(16))) unsigned char lds_raw[];
    LAS unsigned char* lds = (LAS unsigned char*)lds_raw;
    const int n_it = (a.ph_hi - a.ph_lo) * (REPM ? 2 : 1);
    volatile LAS unsigned* xst = (volatile LAS unsigned*)(lds + LDS_XB_OFF);
    if (threadIdx.x < 4) xst[threadIdx.x] = 0u;
    __syncthreads();
    if (a.ph_lo < 0) cg::this_grid().sync();
    const XcdBarrier xbar = xcd_barrier_post((unsigned*)(a.ws + WS_BAR), xst);
    for (int it = 0; it < n_it; ++it) {
        const int ph = a.ph_lo + (REPM ? (it >> 1) : it);
        if (REPM && (it & 1) && !((ph >= 1 && ph < N_PHASES - 1 && ((REPM >> ((ph - 1) & 7)) & 1u)) || (ph == 0 && (REPM & 0x100u)))) continue;
        if (it == 1) xcd_barrier(xbar);
        const bool regular = it >= 1 && __builtin_amdgcn_readfirstlane((int)xst[3]) != 0;
        if (it > 1) { if (regular) xcd_barrier_local(xbar); else xcd_barrier(xbar); }
        const int vb = regular ? __builtin_amdgcn_readfirstlane((int)(xst[2] * 8u + xbar.x)) : (int)blockIdx.x;
        int tid = threadIdx.x; asm volatile("" : "+v"(tid));
        const int lane = tid & 63, wave = __builtin_amdgcn_readfirstlane(tid >> 6);
        const int NGW = gridDim.x * NWAVES, gw = (gridDim.x == 256) ? 256 * (vb & 7) + 8 * (vb >> 3) + wave : vb * NWAVES + wave;
        if (ph == 0) { if (PHM & 1) phase_p0(a, lds, tid, lane, wave); continue; }
        if (ph == N_PHASES - 1) { if (PHM & 2) norm_rows_bf<true>((const bf16_t*)(a.ws + WS_X), a.norm_final, nullptr, nullptr, nullptr, a.out, gw, NGW, lane); continue; }
        const int l = (ph - 1) >> 3, k = (ph - 1) & 7;
        const float* modl = (const float*)(a.ws + WS_MOD) + (size_t)l * NB * 6144;
        bf16_t* H = (bf16_t*)(a.ws + WS_H); bf16_t* Z = (bf16_t*)(a.ws + WS_Z); bf16_t* MIX = (bf16_t*)(a.ws + WS_Z) + MIX_OFF_E; bf16_t* ACT = (bf16_t*)(a.ws + WS_Z);
        const unsigned char* wl = a.ws + WS_W + (size_t)l * W_LAYER;
        bf16_t* XS = (bf16_t*)(a.ws + WS_X);
        if (k == 0) { if (PHM & 4) { if (l == 0) norm_rows<false>(a.x, a.norm_mix + l * DM, modl + 1024, modl, H, nullptr, gw, NGW, lane);
                                         else norm_rows_bf<false>(XS, a.norm_mix + l * DM, modl + 1024, modl, H, nullptr, gw, NGW, lane); } }
        else if (k == 1) { if (PHM & 8) { pg8::Gemm g{H, (const bf16_t*)(wl + W_IN), MTOK, PW, DM, 0}; pg8::StaticOrder S; S.init(MTOK, PW, gridDim.x, vb);
            pg8::EpiZH E{Z}; pg8::gemm_phase<pg8::EpiZH, pg8::StaticOrder, true, true>(lds, g, S, E, tid); } }
        else if (k == 2) { if (PHM & 16) phase_mix(a, l, lds, tid, lane, wave, vb); }
        else if (k == 3) { if (PHM & 32) phase_combine(a, l, lane, gw, NGW); }
        else if (k == 4) { if (PHM & 64) { pg8::Gemm g{MIX, (const bf16_t*)(wl + W_OUT), MTOK, DM, DM, MIX_GAP_E}; pg8::StaticOrder S; S.init(MTOK, DM, gridDim.x, vb);
            if (l == 0) { pg8::EpiResid<true, true> E{a.x, XS, modl + 2048, (const float*)(a.ws + WS_SSC)}; pg8::gemm_phase<pg8::EpiResid<true, true>, pg8::StaticOrder, true, true>(lds, g, S, E, tid); }
            else { pg8::EpiResid<false, true> E{XS, XS, modl + 2048, (const float*)(a.ws + WS_SSC)}; pg8::gemm_phase<pg8::EpiResid<false, true>, pg8::StaticOrder, true, true>(lds, g, S, E, tid); } } }
        else if (k == 5) { if (PHM & 128) norm_rows_bf<false>(XS, a.norm_ffn + l * DM, modl + 4096, modl + 3072, H, nullptr, gw, NGW, lane); }
        else if (k == 6) { if (PHM & 256) { pg8::Gemm g{H, (const bf16_t*)(wl + W_FI), MTOK, 2 * FF, DM, 0}; pg8::StaticOrder S; S.init(MTOK, 2 * FF, gridDim.x, vb);
            pg8::EpiSwiGLU E{ACT, FF, ACT_GAP_E}; pg8::gemm_phase<pg8::EpiSwiGLU, pg8::StaticOrder, true, true>(lds, g, S, E, tid); } }
        else { if (PHM & 512) { pg8::Gemm g{ACT, (const bf16_t*)(wl + W_FO), MTOK, DM, FF, ACT_GAP_E}; pg8::StaticOrder S; S.init(MTOK, DM, gridDim.x, vb);
            pg8::EpiResid<false> E{XS, XS, modl + 5120, nullptr}; pg8::gemm_phase<pg8::EpiResid<false>, pg8::StaticOrder, true, true>(lds, g, S, E, tid); } }
    }
}

extern "C" void kernel_launch(void* const* d_in, const int* in_sizes, int n_in, void* d_out, int out_size, void* d_ws, size_t ws_size, hipStream_t stream) {
    static int grid = 0;
    if (grid == 0) {
        if (n_in != 16 || out_size != MTOK * DM || ws_size < WS_END) { fprintf(stderr, "kernel_launch: unexpected shapes (n_in %d out %d ws %zu)\n", n_in, out_size, ws_size); grid = -1; return; }
        int dev = 0, cus = 0, per_cu = 0;
        hipGetDevice(&dev); hipDeviceGetAttribute(&cus, hipDeviceAttributeMultiprocessorCount, dev);
        if (hipFuncSetAttribute((const void*)fwd_mega, hipFuncAttributeMaxDynamicSharedMemorySize, LDS_BYTES) != hipSuccess) { fprintf(stderr, "kernel_launch: hipFuncSetAttribute failed\n"); grid = -1; return; }
        if (hipOccupancyMaxActiveBlocksPerMultiprocessor(&per_cu, (const void*)fwd_mega, NTHR, LDS_BYTES) != hipSuccess || per_cu < 1) { fprintf(stderr, "kernel_launch: occupancy query says %d\n", per_cu); per_cu = 1; }
        (void)hipGetLastError();
        grid = cus * (per_cu > 1 ? 1 : per_cu);
    }
    if (grid < 0) return;
    if (hipMemsetAsync((char*)d_ws + WS_BAR, 0, 16384, stream) != hipSuccess) { fprintf(stderr, "kernel_launch: memset of the barrier words failed\n"); return; }
    Args a{};
    a.x = (const float*)d_in[0]; a.c = (const float*)d_in[1]; a.w_ada = (const float*)d_in[2]; a.b_ada = (const float*)d_in[3]; a.norm_mix = (const float*)d_in[4];
    a.w_in = (const float*)d_in[5]; a.norm_a_out = (const float*)d_in[6]; a.norm_c_out = (const float*)d_in[7]; a.w_pool = (const float*)d_in[8]; a.pool_scale = (const float*)d_in[9];
    a.rpb = (const float*)d_in[10]; a.w_out = (const float*)d_in[11]; a.norm_ffn = (const float*)d_in[12]; a.w_ffn_in = (const float*)d_in[13]; a.w_ffn_out = (const float*)d_in[14];
    a.norm_final = (const float*)d_in[15]; a.out = (float*)d_out; a.ws = (unsigned char*)d_ws;
#if MK_PER_PHASE
    for (int ph = 0; ph < N_PHASES; ++ph) { a.ph_lo = ph; a.ph_hi = ph + 1; void* args[] = {&a};
        hipError_t e = hipLaunchCooperativeKernel((const void*)fwd_mega, dim3(grid), dim3(NTHR), args, LDS_BYTES, stream);
        if (e != hipSuccess) { fprintf(stderr, "launch %d failed: %s\n", ph, hipGetErrorString(e)); break; } }
#else
    a.ph_lo = 0; a.ph_hi = N_PHASES; void* args[] = {&a};
    hipError_t e = hipLaunchCooperativeKernel((const void*)fwd_mega, dim3(grid), dim3(NTHR), args, LDS_BYTES, stream);
    if (e != hipSuccess) fprintf(stderr, "cooperative launch failed: %s (grid %d)\n", hipGetErrorString(e), grid);
#endif
}
```
